# Optimizing an MI355X kernel written in HIP

```python
import jax, jax.numpy as jnp
from jax import lax
import numpy as np

D_MODEL = 1024
BATCH = 16
SEQ = 4096
DEPTH = 1

N_HEADS_ATTN = 8
HEAD_DIM = 64
ATTN_WIDTH = N_HEADS_ATTN * HEAD_DIM
IDX_HEADS = 8
IDX_DIM = 32
TOPK_MAX = 256
Q_BLOCK = 128
CONV_WIDTH = D_MODEL - ATTN_WIDTH
CONV_GROUPS = 8
CONV_K = 3
MIX_WIDTH = ATTN_WIDTH + CONV_WIDTH
ROPE_THETA = 500000.0
ROPE_DIM = HEAD_DIM // 4
D_FF = ((-(-8 * D_MODEL // 3)) + 255) // 256 * 256
DEEPNORM_ALPHA = (2.0 * DEPTH) ** 0.25
DEEPNORM_BETA = (8.0 * DEPTH) ** -0.25
EPS = 1e-5
NEG_INF = -1e30

IN_SPLITS = (ATTN_WIDTH, HEAD_DIM, HEAD_DIM, IDX_HEADS * IDX_DIM, IDX_DIM, IDX_HEADS,
             CONV_WIDTH, CONV_WIDTH, CONV_WIDTH)
IN_COLS = sum(IN_SPLITS)

kernel_name = "hymba_dsa_shortconv_deepnorm_adaln"


def rope_tables(seq_len):
    pos = jnp.arange(seq_len, dtype=jnp.float32)
    inv = ROPE_THETA ** (-(jnp.arange(0, ROPE_DIM, 2, dtype=jnp.float32) / ROPE_DIM))
    ang = pos[:, None] * inv[None, :]
    return jnp.cos(ang)[:, None, :], jnp.sin(ang)[:, None, :]


def partial_rope(x, cos, sin):
    cos = cos.astype(x.dtype)
    sin = sin.astype(x.dtype)
    half = ROPE_DIM // 2
    x1, x2, rest = x[..., :half], x[..., half:ROPE_DIM], x[..., ROPE_DIM:]
    return jnp.concatenate([x1 * cos - x2 * sin, x2 * cos + x1 * sin, rest], axis=-1)


def layer_norm(x, g, b):
    xf = x.astype(jnp.float32)
    mu = jnp.mean(xf, axis=-1, keepdims=True)
    var = jnp.mean(jnp.square(xf - mu), axis=-1, keepdims=True)
    y = (xf - mu) * lax.rsqrt(var + EPS) * g.astype(jnp.float32) + b.astype(jnp.float32)
    return y.astype(x.dtype)


def group_rms_norm(x, g, n_groups):
    bsz, s, w = x.shape
    xf = x.astype(jnp.float32).reshape(bsz, s, n_groups, w // n_groups)
    xf = xf * lax.rsqrt(jnp.mean(jnp.square(xf), axis=-1, keepdims=True) + EPS)
    return (xf.reshape(bsz, s, w) * g.astype(jnp.float32)).astype(x.dtype)


def modulate(x, shift, scale):
    return x * (1.0 + scale[:, None, :]) + shift[:, None, :]


def sparse_indexer_attention(q, k, v, qi, ki, wi, k_sel):
    bsz, s, h, dh = q.shape
    n_blk = s // Q_BLOCK
    attn_scale = HEAD_DIM ** -0.5
    key_pos = jnp.arange(s)
    ki32 = ki.astype(jnp.float32)

    def to_blocks(a):
        return jnp.moveaxis(a.reshape((bsz, n_blk, Q_BLOCK) + a.shape[2:]), 1, 0)

    def block_fn(args):
        q_b, qi_b, w_b, t_b = args
        rel = jax.nn.relu(jnp.einsum('bqhd,bsd->bqhs', qi_b.astype(jnp.float32), ki32))
        score = jnp.einsum('bqhs,bqh->bqs', rel, w_b.astype(jnp.float32))
        causal = key_pos[None, :] <= t_b[:, None]
        score = jnp.where(causal[None], score, NEG_INF)
        _, sel = lax.top_k(score, k_sel)
        valid = sel <= t_b[None, :, None]
        kg = jax.vmap(lambda kb, ib: kb[ib])(k, sel)
        vg = jax.vmap(lambda vb, ib: vb[ib])(v, sel)
        logits = jnp.einsum('bqhd,bqkd->bhqk', q_b, kg).astype(jnp.float32) * attn_scale
        logits = jnp.where(valid[:, None], logits, NEG_INF)
        p = jax.nn.softmax(logits, axis=-1).astype(v.dtype)
        return jnp.einsum('bhqk,bqkd->bqhd', p, vg)

    t_blocks = key_pos.reshape(n_blk, Q_BLOCK)
    out = lax.map(block_fn, (to_blocks(q), to_blocks(qi), to_blocks(wi), t_blocks))
    return jnp.moveaxis(out, 0, 1).reshape(bsz, s, h, dh)


def token_mixer(h, w_in, conv_w, attn_norm_g, conv_norm_g, w_out, cos, sin):
    bsz, s, _ = h.shape
    k_sel = min(TOPK_MAX, s // 4)
    proj = h @ w_in
    offsets = np.cumsum(IN_SPLITS)[:-1].tolist()
    q, k, v, qi, ki, wi, gate_b, gate_c, hc = jnp.split(proj, offsets, axis=-1)

    q = partial_rope(q.reshape(bsz, s, N_HEADS_ATTN, HEAD_DIM), cos, sin)
    k = partial_rope(k[:, :, None, :], cos, sin)[:, :, 0, :]
    qi = partial_rope(qi.reshape(bsz, s, IDX_HEADS, IDX_DIM), cos, sin)
    ki = partial_rope(ki[:, :, None, :], cos, sin)[:, :, 0, :]
    wi = wi * (IDX_HEADS ** -0.5 * IDX_DIM ** -0.5)
    attn = sparse_indexer_attention(q, k, v, qi, ki, wi, k_sel).reshape(bsz, s, ATTN_WIDTH)
    attn = group_rms_norm(attn, attn_norm_g, N_HEADS_ATTN)

    u = gate_c * hc
    u_pad = jnp.pad(u, ((0, 0), (CONV_K - 1, 0), (0, 0)))
    conv = sum(conv_w[j] * u_pad[:, j:j + s, :] for j in range(CONV_K))
    conv_out = group_rms_norm(gate_b * conv, conv_norm_g, CONV_GROUPS)

    mixed = jnp.concatenate([attn, conv_out], axis=-1)
    return mixed @ w_out


def swiglu(h, w_gate, w_up, w_down):
    return (jax.nn.silu(h @ w_gate) * (h @ w_up)) @ w_down


def setup_inputs(seed: int = 0) -> dict:
    key = jax.random.key(seed)
    ks = jax.random.split(key, 17)
    n = jax.random.normal
    f32 = jnp.float32
    L = DEPTH
    return {
        "x": n(ks[0], (BATCH, SEQ, D_MODEL), f32),
        "c": n(ks[1], (BATCH, D_MODEL), f32),
        "w_ada": n(ks[2], (L, D_MODEL, 6 * D_MODEL), f32) * (D_MODEL ** -0.5),
        "b_ada": n(ks[3], (L, 6 * D_MODEL), f32) * 0.02,
        "w_in": n(ks[4], (L, D_MODEL, IN_COLS), f32) * (D_MODEL ** -0.5),
        "conv_w": n(ks[5], (L, CONV_K, CONV_WIDTH), f32) * (CONV_K ** -0.5),
        "attn_norm_g": 1.0 + 0.1 * n(ks[6], (L, ATTN_WIDTH), f32),
        "conv_norm_g": 1.0 + 0.1 * n(ks[7], (L, CONV_WIDTH), f32),
        "w_out": n(ks[8], (L, MIX_WIDTH, D_MODEL), f32) * (MIX_WIDTH ** -0.5) * DEEPNORM_BETA,
        "ln1_g": 1.0 + 0.1 * n(ks[9], (L, D_MODEL), f32),
        "ln1_b": 0.02 * n(ks[10], (L, D_MODEL), f32),
        "w_gate": n(ks[11], (L, D_MODEL, D_FF), f32) * (D_MODEL ** -0.5),
        "w_up": n(ks[12], (L, D_MODEL, D_FF), f32) * (D_MODEL ** -0.5),
        "w_down": n(ks[13], (L, D_FF, D_MODEL), f32) * (D_FF ** -0.5) * DEEPNORM_BETA,
        "ln2_g": 1.0 + 0.1 * n(ks[14], (L, D_MODEL), f32),
        "ln2_b": 0.02 * n(ks[15], (L, D_MODEL), f32),
    }


def reference(x, c, w_ada, b_ada, w_in, conv_w, attn_norm_g, conv_norm_g, w_out,
              ln1_g, ln1_b, w_gate, w_up, w_down, ln2_g, ln2_b):
    s = x.shape[1]
    cos, sin = rope_tables(s)
    c_act = jax.nn.silu(c)
    for l in range(DEPTH):
        mod = c_act @ w_ada[l] + b_ada[l]
        sh1, sc1, g1, sh2, sc2, g2 = jnp.split(mod, 6, axis=-1)
        mix = token_mixer(modulate(x, sh1, sc1), w_in[l], conv_w[l], attn_norm_g[l],
                          conv_norm_g[l], w_out[l], cos, sin)
        x = layer_norm(DEEPNORM_ALPHA * x + g1[:, None, :] * mix, ln1_g[l], ln1_b[l])
        ff = swiglu(modulate(x, sh2, sc2), w_gate[l], w_up[l], w_down[l])
        x = layer_norm(DEEPNORM_ALPHA * x + g2[:, None, :] * ff, ln2_g[l], ln2_b[l])
    return x
```

```cpp
#include <hip/hip_runtime.h>
#include <cstdio>
#include <cstdint>

#define LAS __attribute__((address_space(3)))
#define GAS __attribute__((address_space(1)))
typedef unsigned short f16_t;
typedef _Float16 f16x8 __attribute__((ext_vector_type(8)));
typedef _Float16 f16x4 __attribute__((ext_vector_type(4)));
typedef _Float16 f16x2 __attribute__((ext_vector_type(2)));
typedef float f32x2 __attribute__((ext_vector_type(2)));
typedef float f32x4 __attribute__((ext_vector_type(4)));
typedef float f32x16 __attribute__((ext_vector_type(16)));
typedef unsigned u32x2 __attribute__((ext_vector_type(2)));
typedef unsigned u32x4 __attribute__((ext_vector_type(4)));
typedef short v4i16_t __attribute__((ext_vector_type(4)));

constexpr int DM = 1024, BATCH = 16, SEQ = 4096, MTOK = BATCH * SEQ;
constexpr int NH = 8, HD = 64, AW = 512, IH = 8, ID = 32, TOPK = 256, CW = 512, DFF = 2816;
constexpr int IN_COLS = 2472, NIN = 2560;
constexpr int NGU = 2 * DFF;
#ifndef SEL16
#define SEL16 1
#endif
#ifndef FFN_BF16
#define FFN_BF16 1
#endif
constexpr bool FFN_BF = FFN_BF16 != 0;
constexpr float EPS = 1e-5f;
constexpr float DN_ALPHA = 1.189207115002721f;
constexpr float QSCALE = 0.125f * 1.4426950408889634f;

typedef __bf16 bf16x8_t __attribute__((ext_vector_type(8)));
typedef __bf16 bf16x2_t __attribute__((ext_vector_type(2)));
__device__ __forceinline__ unsigned pkb(float lo, float hi) { f32x2 v = {lo, hi}; return __builtin_bit_cast(unsigned, __builtin_convertvector(v, bf16x2_t)); }
__device__ __forceinline__ unsigned pkh(float lo, float hi) { f32x2 v = {lo, hi}; return __builtin_bit_cast(unsigned, __builtin_convertvector(v, f16x2)); }
__device__ __forceinline__ float wave_sum(float v) {
#define WS_STEP(ctrl, rm, bc) v += __builtin_bit_cast(float, __builtin_amdgcn_update_dpp(0, __builtin_bit_cast(int, v), ctrl, rm, 0xf, bc))
    WS_STEP(0x111, 0xf, true); WS_STEP(0x112, 0xf, true); WS_STEP(0x114, 0xf, true); WS_STEP(0x118, 0xf, true); WS_STEP(0x142, 0xa, false); WS_STEP(0x143, 0xc, false);
#undef WS_STEP
    return __builtin_bit_cast(float, __builtin_amdgcn_readlane(__builtin_bit_cast(int, v), 63));
}

namespace pg8 {
#define PG8_LAS __attribute__((address_space(3)))
constexpr int BM = 256, BK = 64, HALF = 128, HTB = HALF * BK * 2, STAGE_BYTES = 8 * HTB, NXCD = 8, WGM = 8;
__host__ __device__ __forceinline__ int lds_byte(int r, int c) { const int st = (r >> 4) * 2 + (c >> 5), rr = r & 15, cc = c & 31, ob = rr * 64 + cc * 2; return st * 1024 + (ob ^ (((ob >> 9) & 1) << 5)); }
__host__ __device__ __forceinline__ void stage_rc(int b, int& R, int& C) { const int st = b / 1024, sb = b % 1024, swz = sb ^ (((sb >> 9) & 1) << 5); R = (st >> 1) * 16 + swz / 64; C = (st & 1) * 32 + (swz % 64) / 2; }
__host__ __device__ __forceinline__ int perm32(int rho) { const int n = rho >> 4, i = rho & 15; return 8 * (i >> 2) + 4 * n + (i & 3); }
struct Unit { int pm, pn; };
struct Gemm { const f16_t* A; const f16_t* Bt; int M, N, K; };
struct StaticOrder {
    int nM, nN, nwg, G, c;
    __host__ __device__ void init(int M, int N, int G_, int c_) { nM = M / BM; nN = N / BM; nwg = nM * nN; G = G_; c = c_; }
    __host__ __device__ bool next(int i, Unit& u) const {
        const long L = (long)i * G + c; if (L >= nwg) return false;
        int wgid = (int)L; { const int q = nwg / NXCD, r = nwg % NXCD, xcd = wgid % NXCD, off = wgid / NXCD; wgid = (xcd < r ? xcd * (q + 1) : r * (q + 1) + (xcd - r) * q) + off; }
        const int nig = WGM * nN, gid = wgid / nig, fm = gid * WGM, gsz = (nM - fm) < WGM ? (nM - fm) : WGM;
        u.pm = fm + ((wgid % nig) % gsz); u.pn = (wgid % nig) / gsz; return true;
    }
    __device__ __forceinline__ void a_ready(const Unit&) const {}
    __device__ __forceinline__ void done(const Unit&) const {}
};


struct EpiInProj {
    static constexpr bool PERM = true, AFTER_DRAIN = false;
    f16_t *Q, *K, *V, *QI, *KI, *GB, *U; float* WI; const float* rope;
    __device__ __forceinline__ static void rot8(f32x4& v0, f32x4& v1, const float* rp) {
        const f32x4 c0 = *(const f32x4*)rp, c1 = *(const f32x4*)(rp + 4);
        f32x4 a, b;
        a[0] = v0[0] * c0[0] - v0[1] * c0[1]; a[1] = v0[1] * c0[0] + v0[0] * c0[1];
        a[2] = v0[2] * c0[2] - v0[3] * c0[3]; a[3] = v0[3] * c0[2] + v0[2] * c0[3];
        b[0] = v1[0] * c1[0] - v1[1] * c1[1]; b[1] = v1[1] * c1[0] + v1[0] * c1[1];
        b[2] = v1[2] * c1[2] - v1[3] * c1[3]; b[3] = v1[3] * c1[2] + v1[2] * c1[3];
        v0 = a; v1 = b;
    }
    __device__ __forceinline__ static u32x4 pack8(const f32x4& v0, const f32x4& v1) { u32x4 w; w.x = pkh(v0[0], v0[1]); w.y = pkh(v0[2], v0[3]); w.z = pkh(v1[0], v1[1]); w.w = pkh(v1[2], v1[3]); return w; }
    __device__ __forceinline__ static void rot8_sel(f32x4& v0, f32x4& v1, const f32x4 c0, const f32x4 c1, bool on) {
        f32x4 a, b;
        a[0] = v0[0] * c0[0] - v0[1] * c0[1]; a[1] = v0[1] * c0[0] + v0[0] * c0[1];
        a[2] = v0[2] * c0[2] - v0[3] * c0[3]; a[3] = v0[3] * c0[2] + v0[2] * c0[3];
        b[0] = v1[0] * c1[0] - v1[1] * c1[1]; b[1] = v1[1] * c1[0] + v1[0] * c1[1];
        b[2] = v1[2] * c1[2] - v1[3] * c1[3]; b[3] = v1[3] * c1[2] + v1[2] * c1[3];
        v0 = on ? a : v0; v1 = on ? b : v1;
    }
    __device__ __forceinline__ void operator()(const f32x4 (&acc)[2][2][4][2], const Unit& u, int wr, int wc, int fr, int fq) const {
        const int row0 = u.pm * BM + wr * 64 + fr, pn = u.pn;
        if (pn < 2 || pn == 3) {
            const int hw = (pn == 3) ? 31 : 63;
            f16_t* const dst = (pn == 3) ? QI : Q; const int pitch = (pn == 3) ? IH * ID : AW; const float sc = (pn == 3) ? 1.0f : QSCALE;
            const int cb = (pn == 3) ? 0 : pn * 256;
            int d0[2]; bool on[2];
#pragma unroll
            for (int bj = 0; bj < 2; ++bj) { const int cl = bj * HALF + wc * 32 + 8 * fq; d0[bj] = (cb + cl) & hw; on[bj] = d0[bj] < 16; }
#pragma unroll
            for (int ai = 0; ai < 2; ++ai) {
                f32x4 cs[4][2][2];
#pragma unroll
                for (int m = 0; m < 4; ++m) { const int t = (row0 + ai * HALF + m * 16) & (SEQ - 1); const float* rp = rope + (size_t)t * 16;
#pragma unroll
                    for (int bj = 0; bj < 2; ++bj) { cs[m][bj][0] = *(const f32x4*)(rp + (d0[bj] & 8)); cs[m][bj][1] = *(const f32x4*)(rp + (d0[bj] & 8) + 4); } }
#pragma unroll
                for (int m = 0; m < 4; ++m) { const int row = row0 + ai * HALF + m * 16;
#pragma unroll
                    for (int bj = 0; bj < 2; ++bj) { f32x4 v0 = acc[ai][bj][m][0], v1 = acc[ai][bj][m][1];
                        rot8_sel(v0, v1, cs[m][bj][0], cs[m][bj][1], on[bj]);
                        v0 = v0 * sc; v1 = v1 * sc;
                        *(u32x4*)(dst + (size_t)row * pitch + cb + bj * HALF + wc * 32 + 8 * fq) = pack8(v0, v1); } }
            }
            return;
        }
#pragma unroll
        for (int ai = 0; ai < 2; ++ai)
#pragma unroll
            for (int m = 0; m < 4; ++m) {
                const int row = row0 + ai * HALF + m * 16; const int t = row & (SEQ - 1);
                const float* rp = rope + (size_t)t * 16;
                if (pn >= 6) {
                    const f32x4 g0 = acc[ai][0][m][0], g1 = acc[ai][0][m][1], h0 = acc[ai][1][m][0], h1 = acc[ai][1][m][1];
                    u32x4 w; w.x = pkh(g0[0] * h0[0], g0[1] * h0[1]); w.y = pkh(g0[2] * h0[2], g0[3] * h0[3]); w.z = pkh(g1[0] * h1[0], g1[1] * h1[1]); w.w = pkh(g1[2] * h1[2], g1[3] * h1[3]);
                    *(u32x4*)(U + (size_t)row * CW + (pn - 6) * HALF + wc * 32 + 8 * fq) = w;
                    continue;
                }
#pragma unroll
                for (int bj = 0; bj < 2; ++bj) {
                    f32x4 v0 = acc[ai][bj][m][0], v1 = acc[ai][bj][m][1];
                    const int cl = bj * HALF + wc * 32 + 8 * fq;
                    if (pn == 2) {
                        if (cl < 64) { if (cl < 16) rot8(v0, v1, rp + cl); *(u32x4*)(K + (size_t)row * HD + cl) = pack8(v0, v1); }
                        else if (cl < 128) { *(u32x4*)(V + (size_t)row * HD + (cl - 64)) = pack8(v0, v1); }
                        else if (cl < 160) { const int d0 = cl - 128; if (d0 < 16) rot8(v0, v1, rp + d0); *(u32x4*)(KI + (size_t)row * ID + d0) = pack8(v0, v1); }
                        else if (cl < 168) { float* wp = WI + (size_t)row * IH; *(f32x4*)wp = v0 * 0.0625f; *(f32x4*)(wp + 4) = v1 * 0.0625f; }
                    } else {
                        *(u32x4*)(GB + (size_t)row * CW + (pn - 4) * 256 + cl) = pack8(v0, v1);
                    }
                }
            }
    }
};
template <bool BASE16> struct EpiResGate {
    static constexpr bool PERM = true, AFTER_DRAIN = false;
    const void* base; f16_t* out; const float* gate;
    __device__ __forceinline__ void operator()(const f32x4 (&acc)[2][2][4][2], const Unit& u, int wr, int wc, int fr, int fq) const {
        const int row0 = u.pm * BM + wr * 64 + fr, col0 = u.pn * BM + wc * 32 + 8 * fq;
        const float* gp = gate + (size_t)((u.pm * BM) / SEQ) * (6 * DM) + col0;
        f32x4 gv[2][2];
#pragma unroll
        for (int bj = 0; bj < 2; ++bj)
#pragma unroll
            for (int n = 0; n < 2; ++n) gv[bj][n] = *(const f32x4*)(gp + bj * HALF + 4 * n);
#pragma unroll
        for (int ai = 0; ai < 2; ++ai) {
            f32x4 b0[4][2], b1[4][2]; u32x4 raw[4][2];
#pragma unroll
            for (int m = 0; m < 4; ++m) { const size_t off = (size_t)(row0 + ai * HALF + m * 16) * DM + col0;
#pragma unroll
                for (int bj = 0; bj < 2; ++bj) {
                    if (BASE16) raw[m][bj] = *(const u32x4*)((const f16_t*)base + off + bj * HALF);
                    else { const float* bp = (const float*)base + off + bj * HALF; b0[m][bj] = *(const f32x4*)bp; b1[m][bj] = *(const f32x4*)(bp + 4); } } }
            asm volatile("" ::: "memory");
#pragma unroll
            for (int m = 0; m < 4; ++m) { const size_t off = (size_t)(row0 + ai * HALF + m * 16) * DM + col0;
#pragma unroll
                for (int bj = 0; bj < 2; ++bj) {
                    if (BASE16) { const f16x8 hv = __builtin_bit_cast(f16x8, raw[m][bj]);
                        b0[m][bj] = (f32x4){(float)hv[0], (float)hv[1], (float)hv[2], (float)hv[3]}; b1[m][bj] = (f32x4){(float)hv[4], (float)hv[5], (float)hv[6], (float)hv[7]}; }
                    const f32x4 y0 = b0[m][bj] * DN_ALPHA + gv[bj][0] * acc[ai][bj][m][0], y1 = b1[m][bj] * DN_ALPHA + gv[bj][1] * acc[ai][bj][m][1];
                    u32x4 w; w.x = pkh(y0[0], y0[1]); w.y = pkh(y0[2], y0[3]); w.z = pkh(y1[0], y1[1]); w.w = pkh(y1[2], y1[3]);
                    *(u32x4*)(out + off + bj * HALF) = w; } }
        }
    }
};
struct EpiSwiGLU {
    static constexpr bool PERM = true, AFTER_DRAIN = false;
    f16_t* H;
    __device__ __forceinline__ static float silu(float g) { return g * __builtin_amdgcn_rcpf(1.0f + __builtin_amdgcn_exp2f(-1.4426950408889634f * g)); }
    __device__ __forceinline__ void operator()(const f32x4 (&acc)[2][2][4][2], const Unit& u, int wr, int wc, int fr, int fq) const {
        const int row0 = u.pm * BM + wr * 64 + fr, j = u.pn * HALF + wc * 32 + 8 * fq;
#pragma unroll
        for (int ai = 0; ai < 2; ++ai)
#pragma unroll
            for (int m = 0; m < 4; ++m) { f16_t* rowp = H + (size_t)(row0 + ai * HALF + m * 16) * DFF + j;
                const f32x4 g0 = acc[ai][0][m][0], g1 = acc[ai][0][m][1], u0 = acc[ai][1][m][0], u1 = acc[ai][1][m][1];
                u32x4 w;
                if (FFN_BF) { w.x = pkb(silu(g0[0]) * u0[0], silu(g0[1]) * u0[1]); w.y = pkb(silu(g0[2]) * u0[2], silu(g0[3]) * u0[3]); w.z = pkb(silu(g1[0]) * u1[0], silu(g1[1]) * u1[1]); w.w = pkb(silu(g1[2]) * u1[2], silu(g1[3]) * u1[3]); }
                else { w.x = pkh(silu(g0[0]) * u0[0], silu(g0[1]) * u0[1]); w.y = pkh(silu(g0[2]) * u0[2], silu(g0[3]) * u0[3]); w.z = pkh(silu(g1[0]) * u1[0], silu(g1[1]) * u1[1]); w.w = pkh(silu(g1[2]) * u1[2], silu(g1[3]) * u1[3]); }
                *(u32x4*)rowp = w; }
    }
};

template <class Epi, class Sched, bool ALIGN_EPI = false, bool SP2 = false, bool BF = false>
__device__ __forceinline__ void gemm_phase(PG8_LAS unsigned char* lds, const Gemm g, const Sched& S, const Epi& E) {
    const int tid = threadIdx.x, wid = __builtin_amdgcn_readfirstlane(tid >> 6), lane = tid & 63, wr = wid >> 2, wc = wid & 3, fr = lane & 15, fq = lane >> 4;
    const int K = g.K, nt = K / BK;
    unsigned voffA[2], voffB[2];
#pragma unroll
    for (int i = 0; i < 2; ++i) { int R, C; stage_rc(tid * 16 + i * 8192, R, C); const int Rb = Epi::PERM ? ((R & ~31) + perm32(R & 31)) : R;
        voffA[i] = (unsigned)(R * K + C) * 2u; voffB[i] = (unsigned)(Rb * K + C) * 2u; }
    const size_t kstep = (size_t)(BK * 2);
    const size_t hstep = (size_t)HALF * K * 2;
    const size_t tstep = 2 * hstep;
    const unsigned ldsw = (unsigned)wid * 1024u;
    const int aoff = lds_byte(wr * 64 + fr, fq * 8), boff = lds_byte(wc * 32 + fr, fq * 8);
#define PG8_SA(b, h) (((b) * 2 + (h)) * HTB)
#define PG8_SB(b, h) ((4 + (b) * 2 + (h)) * HTB)
#define PG8_STAGE(bufoff, gbase, voff) do { _Pragma("unroll") for (int _i = 0; _i < 2; ++_i) \
        __builtin_amdgcn_global_load_lds((const unsigned*)((const char*)(gbase) + (voff)[_i]), (PG8_LAS unsigned*)(lds + (bufoff) + ldsw + _i * 8192), 16, 0, 0); } while (0)
#define PG8_LDA(dst, b, h) do { _Pragma("unroll") for (int m = 0; m < 4; ++m) _Pragma("unroll") for (int k = 0; k < 2; ++k) dst[m][k] = *(const PG8_LAS f16x8*)(lds + PG8_SA(b, h) + aoff + m * 2048 + k * 1024); } while (0)
#define PG8_LDB(dst, b, h) do { _Pragma("unroll") for (int n = 0; n < 2; ++n) _Pragma("unroll") for (int k = 0; k < 2; ++k) dst[n][k] = *(const PG8_LAS f16x8*)(lds + PG8_SB(b, h) + boff + n * 2048 + k * 1024); } while (0)
#define PG8_MMA(ai, bj, At, Bt) do { __builtin_amdgcn_s_setprio(1); _Pragma("unroll") for (int m = 0; m < 4; ++m) _Pragma("unroll") for (int n = 0; n < 2; ++n) _Pragma("unroll") for (int k = 0; k < 2; ++k) \
        acc[ai][bj][m][n] = BF ? __builtin_amdgcn_mfma_f32_16x16x32_bf16(__builtin_bit_cast(bf16x8_t, Bt[n][k]), __builtin_bit_cast(bf16x8_t, At[m][k]), acc[ai][bj][m][n], 0, 0, 0) : __builtin_amdgcn_mfma_f32_16x16x32_f16(Bt[n][k], At[m][k], acc[ai][bj][m][n], 0, 0, 0); __builtin_amdgcn_s_setprio(0); } while (0)
#define PG8_WAIT_V(n) asm volatile("s_waitcnt vmcnt(" #n ")" ::: "memory")
#define PG8_WAIT_L(n) asm volatile("s_waitcnt lgkmcnt(" #n ")" ::: "memory")
#define PG8_BAR __builtin_amdgcn_s_barrier()
#define PG8_SCHED __builtin_amdgcn_sched_barrier(0)
    Unit cur, nxt; int ui = 0;
    if (!S.next(0, cur)) return;
    f32x4 acc[2][2][4][2];
#pragma unroll
    for (int a = 0; a < 2; ++a)
#pragma unroll
        for (int b = 0; b < 2; ++b)
#pragma unroll
            for (int m = 0; m < 4; ++m)
#pragma unroll
                for (int n = 0; n < 2; ++n) acc[a][b][m][n] = (f32x4){0.f, 0.f, 0.f, 0.f};
    f16x8 At[4][2], B0[2][2], B1[2][2];
    const char* cA = (const char*)g.A + (size_t)cur.pm * tstep; const char* cB = (const char*)g.Bt + (size_t)cur.pn * tstep;
    S.a_ready(cur);
    if constexpr (SP2) {
        PG8_STAGE(PG8_SB(0, 0), cB, voffB); PG8_STAGE(PG8_SB(0, 1), cB + hstep, voffB); PG8_STAGE(PG8_SA(0, 0), cA, voffA); PG8_STAGE(PG8_SA(0, 1), cA + hstep, voffA);
        if (wr == 1) PG8_BAR;
        PG8_WAIT_V(2); PG8_BAR;
        PG8_STAGE(PG8_SB(1, 0), cB + kstep, voffB); PG8_STAGE(PG8_SA(1, 0), cA + kstep, voffA); PG8_STAGE(PG8_SB(1, 1), cB + hstep + kstep, voffB);
        PG8_WAIT_V(6); PG8_BAR;
    } else {
        PG8_STAGE(PG8_SB(0, 0), cB, voffB); PG8_STAGE(PG8_SA(0, 0), cA, voffA); PG8_STAGE(PG8_SB(0, 1), cB + hstep, voffB); PG8_STAGE(PG8_SA(0, 1), cA + hstep, voffA);
        if (wr == 1) PG8_BAR;
        PG8_WAIT_V(4); PG8_BAR;
        PG8_STAGE(PG8_SB(1, 0), cB + kstep, voffB); PG8_STAGE(PG8_SA(1, 0), cA + kstep, voffA); PG8_STAGE(PG8_SB(1, 1), cB + hstep + kstep, voffB);
        PG8_WAIT_V(6); PG8_BAR;
    }
    for (;;) {
        const bool has_next = S.next(ui + 1, nxt);
        const char* nA = has_next ? (const char*)g.A + (size_t)nxt.pm * tstep : cA; const char* nB = has_next ? (const char*)g.Bt + (size_t)nxt.pn * tstep : cB;
        for (int t = 0; t < nt; t += 2) {
            const bool last = (t == nt - 2);
            const char* a1 = cA + (size_t)(t + 1) * kstep;
            const char* a2 = last ? nA : cA + (size_t)(t + 2) * kstep; const char* b2 = last ? nB : cB + (size_t)(t + 2) * kstep;
            const char* a3 = a2 + kstep; const char* b3 = b2 + kstep;
            if (last && has_next) S.a_ready(nxt);
            if constexpr (SP2) {
            PG8_LDB(B0, 0, 0); PG8_LDB(B1, 0, 1); PG8_SCHED; PG8_LDA(At, 0, 0); PG8_STAGE(PG8_SA(1, 1), a1 + hstep, voffA);
            PG8_WAIT_V(8); PG8_WAIT_L(0); PG8_BAR; PG8_MMA(0, 0, At, B0); PG8_MMA(0, 1, At, B1); PG8_BAR; PG8_SCHED;
            PG8_LDA(At, 0, 1); PG8_STAGE(PG8_SB(0, 0), b2, voffB); PG8_STAGE(PG8_SB(0, 1), b2 + hstep, voffB); PG8_STAGE(PG8_SA(0, 0), a2, voffA);
            PG8_WAIT_V(8); PG8_WAIT_L(0); PG8_BAR; PG8_MMA(1, 0, At, B0); PG8_MMA(1, 1, At, B1); PG8_BAR; PG8_SCHED;
            PG8_LDB(B0, 1, 0); PG8_LDB(B1, 1, 1); PG8_SCHED; PG8_LDA(At, 1, 0); PG8_STAGE(PG8_SA(0, 1), a2 + hstep, voffA);
            PG8_WAIT_V(8); PG8_WAIT_L(0); PG8_BAR; PG8_MMA(0, 0, At, B0); PG8_MMA(0, 1, At, B1); PG8_BAR; PG8_SCHED;
            PG8_LDA(At, 1, 1); PG8_STAGE(PG8_SB(1, 0), b3, voffB); PG8_STAGE(PG8_SB(1, 1), b3 + hstep, voffB); PG8_STAGE(PG8_SA(1, 0), a3, voffA);
            PG8_WAIT_V(8); PG8_WAIT_L(0); PG8_BAR; PG8_MMA(1, 0, At, B0); PG8_MMA(1, 1, At, B1); PG8_BAR; PG8_SCHED;
            } else {
            PG8_LDB(B0, 0, 0); PG8_SCHED; PG8_LDA(At, 0, 0); PG8_STAGE(PG8_SA(1, 1), a1 + hstep, voffA);
            PG8_WAIT_L(8); PG8_BAR; PG8_WAIT_L(0); PG8_MMA(0, 0, At, B0); PG8_BAR; PG8_SCHED;
            PG8_LDB(B1, 0, 1); PG8_STAGE(PG8_SB(0, 0), b2, voffB);
            PG8_BAR; PG8_WAIT_L(0); PG8_MMA(0, 1, At, B1); PG8_BAR;
            PG8_LDA(At, 0, 1); PG8_STAGE(PG8_SA(0, 0), a2, voffA);
            PG8_BAR; PG8_WAIT_L(0); PG8_MMA(1, 0, At, B0); PG8_BAR; PG8_SCHED;
            PG8_STAGE(PG8_SB(0, 1), b2 + hstep, voffB);
            PG8_WAIT_V(6); PG8_BAR; PG8_MMA(1, 1, At, B1); PG8_BAR;
            PG8_LDB(B0, 1, 0); PG8_SCHED; PG8_LDA(At, 1, 0); PG8_STAGE(PG8_SA(0, 1), a2 + hstep, voffA);
            PG8_WAIT_L(8); PG8_BAR; PG8_WAIT_L(0); PG8_MMA(0, 0, At, B0); PG8_BAR; PG8_SCHED;
            PG8_LDB(B1, 1, 1); PG8_STAGE(PG8_SB(1, 0), b3, voffB);
            PG8_BAR; PG8_WAIT_L(0); PG8_MMA(0, 1, At, B1); PG8_BAR;
            PG8_LDA(At, 1, 1); PG8_STAGE(PG8_SA(1, 0), a3, voffA);
            PG8_BAR; PG8_WAIT_L(0); PG8_MMA(1, 0, At, B0); PG8_BAR; PG8_SCHED;
            PG8_STAGE(PG8_SB(1, 1), b3 + hstep, voffB);
            PG8_WAIT_V(6); PG8_BAR; PG8_MMA(1, 1, At, B1); PG8_BAR;
            }
        }
        if constexpr (ALIGN_EPI) { if (wr == 0) PG8_BAR; }
        if constexpr (!Epi::AFTER_DRAIN) { E(acc, cur, wr, wc, fr, fq); S.done(cur); }
        if (!has_next) break;
#pragma unroll
        for (int a = 0; a < 2; ++a)
#pragma unroll
            for (int b = 0; b < 2; ++b)
#pragma unroll
                for (int m = 0; m < 4; ++m)
#pragma unroll
                    for (int n = 0; n < 2; ++n) acc[a][b][m][n] = (f32x4){0.f, 0.f, 0.f, 0.f};
        cur = nxt; cA = nA; cB = nB; ++ui;
        if constexpr (ALIGN_EPI) { if (wr == 1) PG8_BAR; }
    }
    PG8_WAIT_V(0);
    if constexpr (!ALIGN_EPI) { if (wr == 0) PG8_BAR; }
    PG8_BAR;
    if constexpr (Epi::AFTER_DRAIN) { E.fused(acc, cur, wr, wc, fr, fq, lds, wid, lane); S.done(cur); }
#undef PG8_SA
#undef PG8_SB
#undef PG8_STAGE
#undef PG8_LDA
#undef PG8_LDB
#undef PG8_MMA
#undef PG8_WAIT_V
#undef PG8_WAIT_L
#undef PG8_BAR
#undef PG8_SCHED
}
}

constexpr size_t MiB = 1u << 20;
constexpr size_t WS_CTL = 0, CTL_ZERO_BYTES = 64 * 1024;
constexpr size_t WS_MODP = 1 * MiB;
constexpr size_t WS_MOD = 4 * MiB;
constexpr size_t WS_ROPE = 5 * MiB;
constexpr size_t WS_WIN = 6 * MiB;
constexpr size_t WS_WOUT = 11 * MiB;
constexpr size_t WS_WGU = 13 * MiB;
constexpr size_t WS_WDN = 24 * MiB;
constexpr size_t WS_XN = 32 * MiB;
constexpr size_t WS_Q = 160 * MiB;
constexpr size_t WS_K = 224 * MiB;
constexpr size_t WS_V = 232 * MiB;
constexpr size_t WS_QI = 240 * MiB;
constexpr size_t WS_KI = 272 * MiB;
constexpr size_t WS_WI = 276 * MiB;
constexpr size_t WS_GB = 278 * MiB;
constexpr size_t WS_U = 342 * MiB;
constexpr size_t WS_MIX = 406 * MiB;
constexpr size_t WS_H = 160 * MiB;
constexpr size_t WS_X1 = 544 * MiB;
constexpr size_t WS_END = 800 * MiB;
static_assert(WS_H + (size_t)MTOK * DFF * 2 <= WS_X1 && WS_MIX + (size_t)MTOK * DM * 2 <= WS_X1, "ws map");
constexpr int CW_BAR = 1024;

constexpr int RING_OFF = 0, RING_BYTES = 131072;
constexpr int LDSCTL_OFF = RING_BYTES + 16384 + 4096 + 256 + 8192, MISC_OFF = LDSCTL_OFF + 320;
constexpr int LDS_BYTES = 162048;
constexpr int NWAVES = 8;

#define LDS_WAIT() asm volatile("s_waitcnt lgkmcnt(0)" ::: "memory")
#define VM_WAIT() asm volatile("s_waitcnt vmcnt(0)" ::: "memory")

#define XB_TMO      128
#define XB_XCNT(j)  (256  + 64 * (j))
#define XB_XSUB(j)  (1280 + 64 * (j))
#define XB_XGEN(j)  (2304 + 64 * (j))
#define XB_TOP      3328
#define XB_TOPGEN   3392
#define XCD_BAR_WORDS 3456
#define XB_SPIN_CAP (1u << 20)

__device__ __forceinline__ unsigned xb_ld(unsigned* p)              { return __hip_atomic_load(p, __ATOMIC_RELAXED, __HIP_MEMORY_SCOPE_AGENT); }
__device__ __forceinline__ unsigned xb_add(unsigned* p, unsigned v) { return __hip_atomic_fetch_add(p, v, __ATOMIC_RELAXED, __HIP_MEMORY_SCOPE_AGENT); }
__device__ __forceinline__ unsigned xb_xcc_id() { return (unsigned)__builtin_amdgcn_s_getreg((3 << 11) | 20) & 0xFu; }
#define XB_SPIN(cond, bar) do { unsigned _sp = 0; while (cond) { __builtin_amdgcn_s_sleep(1); \
    if ((++_sp & 255u) == 0u) { if (xb_ld(&(bar)[XB_TMO])) break; if (_sp > XB_SPIN_CAP) { atomicAdd(&(bar)[XB_TMO], 1u); break; } } } } while (0)

struct XcdBarrier {
    unsigned* bar; unsigned x;
    volatile LAS unsigned* st;
};

__device__ __forceinline__ XcdBarrier xcd_barrier_post(unsigned* bar, volatile LAS unsigned* st) {
    XcdBarrier b; b.bar = bar; b.x = xb_xcc_id(); b.st = st;
    if (threadIdx.x == 0) (void)xb_add(&bar[XB_XCNT(b.x)], 1u);
    return b;
}
__device__ __forceinline__ void xcd_barrier_complete(unsigned* bar, unsigned x, unsigned& nloc, unsigned& nx) {
    const unsigned G = gridDim.x * gridDim.y * gridDim.z;
    unsigned sum, cnt, mine, sp = 0u;
    for (;;) {
        sum = 0u; cnt = 0u; mine = 0u;
#pragma unroll
        for (unsigned j = 0; j < 16; ++j) { const unsigned c = xb_ld(&bar[XB_XCNT(j)]); sum += c; cnt += (c > 0u) ? 1u : 0u; mine = (j == x) ? c : mine; }
        if (sum == G) break;
        __builtin_amdgcn_s_sleep(1);
        if ((++sp & 255u) == 0u) { if (xb_ld(&bar[XB_TMO])) break; if (sp > XB_SPIN_CAP) { atomicAdd(&bar[XB_TMO], 1u); break; } }
    }
    nloc = mine > 0u ? mine : 1u; nx = cnt > 0u ? cnt : 1u;
}

__device__ __forceinline__ void xcd_barrier(const XcdBarrier& b) {
    asm volatile("s_waitcnt vmcnt(0)" ::: "memory");
    __syncthreads();
    if (threadIdx.x == 0) {
        unsigned* bar = b.bar;
        __builtin_amdgcn_s_waitcnt(0);
        unsigned nloc = b.st[0], nx = b.st[1];
        if (nloc == 0u) { xcd_barrier_complete(bar, b.x, nloc, nx); b.st[0] = nloc; b.st[1] = nx; }
        const unsigned old = xb_add(&bar[XB_XSUB(b.x)], 1u);
        const unsigned gen = old / nloc;
        if (old + 1u == (gen + 1u) * nloc) {
            __builtin_amdgcn_fence(__ATOMIC_RELEASE, "agent");
            asm volatile("s_waitcnt vmcnt(0)" ::: "memory");
            const unsigned og = xb_add(&bar[XB_TOP], 1u);
            const unsigned tg = og / nx;
            if (og + 1u == (tg + 1u) * nx) xb_add(&bar[XB_TOPGEN], 1u);
            else XB_SPIN(xb_ld(&bar[XB_TOPGEN]) == tg, bar);
            __builtin_amdgcn_fence(__ATOMIC_ACQUIRE, "agent");
            xb_add(&bar[XB_XGEN(b.x)], 1u);
            asm volatile("s_waitcnt vmcnt(0)" ::: "memory");
        } else {
            XB_SPIN(xb_ld(&bar[XB_XGEN(b.x)]) == gen, bar);
            __builtin_amdgcn_fence(__ATOMIC_ACQUIRE, "agent");
            asm volatile("s_waitcnt vmcnt(0)" ::: "memory");
        }
    }
    __syncthreads();
}

struct Frame {
    LAS unsigned char* lds;
    volatile LAS unsigned* MISC;
    unsigned* ctl;
    int tid, lane, wave, vcu, G;
    const float *x, *c, *w_ada, *b_ada, *w_in, *conv_w, *attn_g, *conv_g, *w_out, *ln1_g, *ln1_b, *w_gate, *w_up, *w_down, *ln2_g, *ln2_b;
    float* out;
    float *MODP, *MOD, *ROPE, *WI;
    f16_t *X1H, *YH;
    f16_t *WIN, *WOUT, *WGU, *WDN, *XN, *Q, *K, *V, *QI, *KI, *GB, *U, *MIX, *H;
};

__device__ __forceinline__ int rperm(int d) { return d < 8 ? 2 * d : (d < 16 ? 2 * (d - 8) + 1 : d); }
__device__ __forceinline__ int inproj_dst(int c) {
    if (c < 512) return (c & ~63) + rperm(c & 63);
    if (c < 576) return 512 + rperm(c - 512);
    if (c < 640) return c;
    if (c < 896) { const int e = c - 640; return 768 + (e & ~31) + rperm(e & 31); }
    if (c < 928) return 640 + rperm(c - 896);
    if (c < 936) return 672 + (c - 928);
    if (c < 1448) return 1024 + (c - 936);
    if (c < 1960) { const int j = c - 1448; return 1536 + (j >> 7) * 256 + (j & 127); }
    { const int j = c - 1960; return 1536 + (j >> 7) * 256 + 128 + (j & 127); }
}
template <int MODE, bool BF = false> __device__ __forceinline__ void p0_transpose_item(const float* W, int K, int N, f16_t* WT, LAS float* scr, int item, int lane) {
    const int nblk = (N + 31) / 32, kb = item / nblk, nb = item % nblk, k0 = 64 * kb, n0 = 32 * nb;
    const int colr = n0 + (lane & 31);
#pragma unroll 8
    for (int i = 0; i < 32; ++i) { const int kk = 2 * i + (lane >> 5); scr[kk * 33 + (lane & 31)] = colr < N ? W[(size_t)(k0 + kk) * N + colr] : 0.f; }
    LDS_WAIT(); asm volatile("" ::: "memory");
    const int c = lane & 7;
#pragma unroll
    for (int j = 0; j < 4; ++j) { const int n = (lane >> 3) + 8 * j; const int col = n0 + n; const LAS float* s = scr + (8 * c) * 33 + n;
        u32x4 o; if (BF) { o.x = pkb(s[0 * 33], s[1 * 33]); o.y = pkb(s[2 * 33], s[3 * 33]); o.z = pkb(s[4 * 33], s[5 * 33]); o.w = pkb(s[6 * 33], s[7 * 33]); }
        else { o.x = pkh(s[0 * 33], s[1 * 33]); o.y = pkh(s[2 * 33], s[3 * 33]); o.z = pkh(s[4 * 33], s[5 * 33]); o.w = pkh(s[6 * 33], s[7 * 33]); }
        if (col < N) { int dr = col; if (MODE == 1) dr = inproj_dst(col); if (MODE == 2) dr = (col >> 7) * 256 + (col & 127); if (MODE == 3) dr = (col >> 7) * 256 + 128 + (col & 127);
            *(u32x4*)(WT + (size_t)dr * K + k0 + 8 * c) = o; } }
    LDS_WAIT(); asm volatile("" ::: "memory");
}
__device__ __forceinline__ void p0_ada_item(Frame& F, LAS float* scr, int item) {
    const int cb = item % 96, ks = item / 96, k0 = ks * 128, lane = F.lane;
#pragma unroll 4
    for (int i = 0; i < 32; ++i) { const int idx = lane + 64 * i, b = idx >> 7, kk = idx & 127; const float cv = F.c[b * DM + k0 + kk];
        scr[kk * 16 + b] = cv / (1.0f + __expf(-cv)); }
    LDS_WAIT(); asm volatile("" ::: "memory");
    float acc[16];
#pragma unroll
    for (int b = 0; b < 16; ++b) acc[b] = 0.f;
    const float* wp = F.w_ada + (size_t)k0 * (6 * DM) + cb * 64 + lane;
#pragma unroll 4
    for (int kk = 0; kk < 128; ++kk) { const float wv = wp[(size_t)kk * (6 * DM)];
        const LAS f32x4* sp = (const LAS f32x4*)(scr + kk * 16);
        const f32x4 s0 = sp[0], s1 = sp[1], s2 = sp[2], s3 = sp[3];
        acc[0] += s0[0] * wv; acc[1] += s0[1] * wv; acc[2] += s0[2] * wv; acc[3] += s0[3] * wv;
        acc[4] += s1[0] * wv; acc[5] += s1[1] * wv; acc[6] += s1[2] * wv; acc[7] += s1[3] * wv;
        acc[8] += s2[0] * wv; acc[9] += s2[1] * wv; acc[10] += s2[2] * wv; acc[11] += s2[3] * wv;
        acc[12] += s3[0] * wv; acc[13] += s3[1] * wv; acc[14] += s3[2] * wv; acc[15] += s3[3] * wv; }
#pragma unroll
    for (int b = 0; b < 16; ++b) F.MODP[(size_t)(ks * 16 + b) * (6 * DM) + cb * 64 + lane] = acc[b];
    LDS_WAIT(); asm volatile("" ::: "memory");
}
__device__ __forceinline__ void sincos_d(double a, float& cs, float& sn) {
    const double TWO_PI = 6.283185307179586476925286766559, INV_2PI = 0.15915494309189533576888376337251;
    const double n = __builtin_rint(a * INV_2PI); const double r = a - n * TWO_PI, r2 = r * r;
    double s = 1.0, c = 1.0;
#pragma unroll
    for (int k = 14; k >= 1; --k) { s = 1.0 - s * r2 / (double)((2 * k) * (2 * k + 1)); c = 1.0 - c * r2 / (double)((2 * k - 1) * (2 * k)); }
    sn = (float)(s * r); cs = (float)c;
}
__device__ __forceinline__ void p0_prologue(Frame& F) {
    LAS float* scr = (LAS float*)(F.lds + RING_OFF + F.wave * 16384);
    const int gw = F.vcu * NWAVES + F.wave, NGW = F.G * NWAVES;
    constexpr int I_ADA = 96 * 8;
    constexpr int I_IN = (DM / 64) * ((IN_COLS + 31) / 32), I_OUT = (DM / 64) * (DM / 32), I_G = (DM / 64) * (DFF / 32), I_DN = (DFF / 64) * (DM / 32);
    constexpr int NITEMS = I_ADA + I_IN + I_OUT + 2 * I_G + I_DN;
    for (int it = gw; it < NITEMS; it += NGW) {
        int r = it;
        if (r < I_ADA) { p0_ada_item(F, scr, r); continue; } r -= I_ADA;
        if (r < I_IN) { p0_transpose_item<1>(F.w_in, DM, IN_COLS, F.WIN, scr, r, F.lane); continue; } r -= I_IN;
        if (r < I_OUT) { p0_transpose_item<0>(F.w_out, DM, DM, F.WOUT, scr, r, F.lane); continue; } r -= I_OUT;
        if (r < I_G) { p0_transpose_item<2, FFN_BF>(F.w_gate, DM, DFF, F.WGU, scr, r, F.lane); continue; } r -= I_G;
        if (r < I_G) { p0_transpose_item<3, FFN_BF>(F.w_up, DM, DFF, F.WGU, scr, r, F.lane); continue; } r -= I_G;
        p0_transpose_item<0, FFN_BF>(F.w_down, DFF, DM, F.WDN, scr, r, F.lane);
    }
    { const int gt = F.vcu * (NWAVES * 64) + F.tid, NT = F.G * NWAVES * 64;
      for (int i = gt; i < 88 * 128; i += NT) *(u32x4*)(F.WIN + (size_t)680 * DM + (size_t)i * 8) = (u32x4){0u, 0u, 0u, 0u};
      const float invf[8] = {1.0f, 0x1.8d275ep-3f, 0x1.341190p-5f, 0x1.ddee9cp-8f, 0x1.72ba44p-10f, 0x1.1f91f0p-12f, 0x1.be218ap-15f, 0x1.5a0f50p-17f};
      for (int e = gt; e < SEQ * 8; e += NT) { const int t = e >> 3, i = e & 7; float fi = invf[0];
#pragma unroll
          for (int k = 1; k < 8; ++k) fi = (i == k) ? invf[k] : fi;
          const float ang = (float)t * fi; float cs, sn; sincos_d((double)ang, cs, sn); *(f32x2*)(F.ROPE + (size_t)e * 2) = (f32x2){cs, sn}; } }
}
__device__ __forceinline__ void p1_modulate(Frame& F) {
    LAS float* tab = (LAS float*)(F.lds + RING_OFF);
    { const int gt = F.vcu * (NWAVES * 64) + F.tid, NT = F.G * NWAVES * 64;
      for (int e = gt; e < 16 * 6 * DM; e += NT) { const int col = e % (6 * DM); float s = F.b_ada[col];
#pragma unroll
          for (int ks = 0; ks < 8; ++ks) s += F.MODP[(size_t)ks * (16 * 6 * DM) + e];
          F.MOD[e] = s; } }
    for (int blk = F.vcu; blk < MTOK / 256; blk += F.G) {
        const int b = blk / (SEQ / 256);
        __syncthreads();
        for (int e = F.tid; e < 2048; e += NWAVES * 64) { float s = F.b_ada[e];
#pragma unroll
            for (int ks = 0; ks < 8; ++ks) s += F.MODP[(size_t)(ks * 16 + b) * (6 * DM) + e];
            tab[e] = s; }
        __syncthreads();
        for (int rr = 0; rr < 32; rr += 4) { const size_t m = (size_t)blk * 256 + F.wave * 32 + rr;
            f32x4 v[4][4];
#pragma unroll
            for (int r = 0; r < 4; ++r) { const f32x4* xr = (const f32x4*)(F.x + (m + r) * DM) + F.lane;
#pragma unroll
                for (int j = 0; j < 4; ++j) v[r][j] = xr[64 * j]; }
#pragma unroll
            for (int j = 0; j < 4; ++j) { const int col = 4 * (F.lane + 64 * j);
                const f32x4 sh = *(const LAS f32x4*)(tab + col), sc = *(const LAS f32x4*)(tab + 1024 + col) + 1.0f;
#pragma unroll
                for (int r = 0; r < 4; ++r) { const f32x4 h = v[r][j] * sc + sh; u32x2 w; w.x = pkh(h[0], h[1]); w.y = pkh(h[2], h[3]); ((u32x2*)(F.XN + (m + r) * DM) + F.lane)[64 * j] = w; } } }
    }
}
template <int MODE> __device__ __forceinline__ void ln_rows(Frame& F, const f16_t* Y, const float* g, const float* bb) {
    const int gw = F.vcu * NWAVES + F.wave, NGW = F.G * NWAVES;
    f32x4 gv[2][2], bv[2][2];
#pragma unroll
    for (int j = 0; j < 2; ++j)
#pragma unroll
        for (int h = 0; h < 2; ++h) { const int col = 8 * (F.lane + 64 * j) + 4 * h; gv[j][h] = *(const f32x4*)(g + col); bv[j][h] = *(const f32x4*)(bb + col); }
    for (int m0 = gw; m0 < MTOK; m0 += 2 * NGW) {
        u32x4 raw[2][2];
#pragma unroll
        for (int r = 0; r < 2; ++r) { const int m = m0 + r * NGW; const u32x4* yr = (const u32x4*)(Y + (size_t)(m < MTOK ? m : m0) * DM) + F.lane; raw[r][0] = yr[0]; raw[r][1] = yr[64]; }
#pragma unroll
        for (int r = 0; r < 2; ++r) { const int m = m0 + r * NGW; if (m >= MTOK) break;
        f32x4 v[2][2]; float s = 0.f;
#pragma unroll
        for (int j = 0; j < 2; ++j) { const f16x8 hv = __builtin_bit_cast(f16x8, raw[r][j]);
            v[j][0] = (f32x4){(float)hv[0], (float)hv[1], (float)hv[2], (float)hv[3]}; v[j][1] = (f32x4){(float)hv[4], (float)hv[5], (float)hv[6], (float)hv[7]};
            s += ((v[j][0][0] + v[j][0][1]) + (v[j][0][2] + v[j][0][3])) + ((v[j][1][0] + v[j][1][1]) + (v[j][1][2] + v[j][1][3])); }
        const float mean = wave_sum(s) * (1.f / DM); float s2 = 0.f;
#pragma unroll
        for (int j = 0; j < 2; ++j)
#pragma unroll
            for (int h = 0; h < 2; ++h) { v[j][h] = v[j][h] - mean; s2 += (v[j][h][0] * v[j][h][0] + v[j][h][1] * v[j][h][1]) + (v[j][h][2] * v[j][h][2] + v[j][h][3] * v[j][h][3]); }
        const float rstd = 1.0f / sqrtf(wave_sum(s2) * (1.f / DM) + EPS);
        if (MODE == 0) {
            const int b = m / SEQ; const float* md = F.MOD + (size_t)b * (6 * DM);
            u32x4* x1r = (u32x4*)(F.X1H + (size_t)m * DM) + F.lane; u32x4* xo = (u32x4*)(F.XN + (size_t)m * DM) + F.lane;
#pragma unroll
            for (int j = 0; j < 2; ++j) { f32x4 x1[2], hh[2];
#pragma unroll
                for (int h = 0; h < 2; ++h) { const int col = 8 * (F.lane + 64 * j) + 4 * h; x1[h] = v[j][h] * rstd * gv[j][h] + bv[j][h];
                    const f32x4 sh = *(const f32x4*)(md + 3 * DM + col), sc = *(const f32x4*)(md + 4 * DM + col); hh[h] = x1[h] * (sc + 1.0f) + sh; }
                u32x4 w; w.x = pkh(x1[0][0], x1[0][1]); w.y = pkh(x1[0][2], x1[0][3]); w.z = pkh(x1[1][0], x1[1][1]); w.w = pkh(x1[1][2], x1[1][3]); x1r[64 * j] = w;
                u32x4 q; if (FFN_BF) { q.x = pkb(hh[0][0], hh[0][1]); q.y = pkb(hh[0][2], hh[0][3]); q.z = pkb(hh[1][0], hh[1][1]); q.w = pkb(hh[1][2], hh[1][3]); }
                else { q.x = pkh(hh[0][0], hh[0][1]); q.y = pkh(hh[0][2], hh[0][3]); q.z = pkh(hh[1][0], hh[1][1]); q.w = pkh(hh[1][2], hh[1][3]); } xo[64 * j] = q; }
        } else {
            float* orow = F.out + (size_t)m * DM;
#pragma unroll
            for (int j = 0; j < 2; ++j)
#pragma unroll
                for (int h = 0; h < 2; ++h) { const int col = 8 * (F.lane + 64 * j) + 4 * h; *(f32x4*)(orow + col) = v[j][h] * rstd * gv[j][h] + bv[j][h]; }
        }
        }
    }
}

__device__ __forceinline__ f32x4 mfma16(f16x8 a, f16x8 b, f32x4 c) { return __builtin_amdgcn_mfma_f32_16x16x32_f16(a, b, c, 0, 0, 0); }
__device__ __forceinline__ f32x16 mfma32(f16x8 a, f16x8 b, f32x16 c) { return __builtin_amdgcn_mfma_f32_32x32x16_f16(a, b, c, 0, 0, 0); }
__device__ __forceinline__ int wave_sum_i(int v) { return __builtin_amdgcn_readfirstlane(__reduce_add_sync(~0ull, v)); }

__device__ __forceinline__ void conv_rows(Frame& F) {
    const int gw = F.vcu * NWAVES + F.wave, NGW = F.G * NWAVES, lane = F.lane;
    float w0[8], w1[8], w2[8], gn[8];
#pragma unroll
    for (int e = 0; e < 8; ++e) { w0[e] = F.conv_w[8 * lane + e]; w1[e] = F.conv_w[CW + 8 * lane + e]; w2[e] = F.conv_w[2 * CW + 8 * lane + e]; gn[e] = F.conv_g[8 * lane + e]; }
    for (int m = gw; m < MTOK; m += NGW) {
        const int t = m & (SEQ - 1);
        const f16x8 z = {0, 0, 0, 0, 0, 0, 0, 0};
        const f16x8 u0 = *(const f16x8*)(F.U + (size_t)m * CW + 8 * lane);
        const f16x8 u1 = t >= 1 ? *(const f16x8*)(F.U + (size_t)(m - 1) * CW + 8 * lane) : z;
        const f16x8 u2 = t >= 2 ? *(const f16x8*)(F.U + (size_t)(m - 2) * CW + 8 * lane) : z;
        const f16x8 gb = *(const f16x8*)(F.GB + (size_t)m * CW + 8 * lane);
        float y[8]; float ss = 0.f;
#pragma unroll
        for (int e = 0; e < 8; ++e) { const float cv = w0[e] * (float)u2[e] + w1[e] * (float)u1[e] + w2[e] * (float)u0[e]; y[e] = (float)gb[e] * cv; ss += y[e] * y[e]; }
        ss += __shfl_xor(ss, 1); ss += __shfl_xor(ss, 2); ss += __shfl_xor(ss, 4);
        const float rstd = 1.0f / sqrtf(ss * (1.f / 64.f) + EPS);
        u32x4 o; o.x = pkh(y[0] * rstd * gn[0], y[1] * rstd * gn[1]); o.y = pkh(y[2] * rstd * gn[2], y[3] * rstd * gn[3]);
        o.z = pkh(y[4] * rstd * gn[4], y[5] * rstd * gn[5]); o.w = pkh(y[6] * rstd * gn[6], y[7] * rstd * gn[7]);
        *(u32x4*)(F.MIX + (size_t)m * DM + AW + 8 * lane) = o;
    }
}

__device__ __forceinline__ void conv_row_one(Frame& F, int m, int lane) {
    const int t = m & (SEQ - 1);
    const f16x8 z = {0, 0, 0, 0, 0, 0, 0, 0};
    const f16x8 u0 = *(const f16x8*)(F.U + (size_t)m * CW + 8 * lane);
    const f16x8 u1 = t >= 1 ? *(const f16x8*)(F.U + (size_t)(m - 1) * CW + 8 * lane) : z;
    const f16x8 u2 = t >= 2 ? *(const f16x8*)(F.U + (size_t)(m - 2) * CW + 8 * lane) : z;
    const f16x8 gb = *(const f16x8*)(F.GB + (size_t)m * CW + 8 * lane);
    const f32x4 w0a = *(const f32x4*)(F.conv_w + 8 * lane), w0b = *(const f32x4*)(F.conv_w + 8 * lane + 4), w1a = *(const f32x4*)(F.conv_w + CW + 8 * lane), w1b = *(const f32x4*)(F.conv_w + CW + 8 * lane + 4);
    const f32x4 w2a = *(const f32x4*)(F.conv_w + 2 * CW + 8 * lane), w2b = *(const f32x4*)(F.conv_w + 2 * CW + 8 * lane + 4), gna = *(const f32x4*)(F.conv_g + 8 * lane), gnb = *(const f32x4*)(F.conv_g + 8 * lane + 4);
    float y[8]; float ss = 0.f;
#pragma unroll
    for (int e = 0; e < 8; ++e) { const float a0 = e < 4 ? w0a[e & 3] : w0b[e & 3], a1 = e < 4 ? w1a[e & 3] : w1b[e & 3], a2 = e < 4 ? w2a[e & 3] : w2b[e & 3];
        const float cv = a0 * (float)u2[e] + a1 * (float)u1[e] + a2 * (float)u0[e]; y[e] = (float)gb[e] * cv; ss += y[e] * y[e]; }
    ss += __shfl_xor(ss, 1); ss += __shfl_xor(ss, 2); ss += __shfl_xor(ss, 4);
    const float rstd = 1.0f / sqrtf(ss * (1.f / 64.f) + EPS);
    u32x4 o; o.x = pkh(y[0] * rstd * gna[0], y[1] * rstd * gna[1]); o.y = pkh(y[2] * rstd * gna[2], y[3] * rstd * gna[3]);
    o.z = pkh(y[4] * rstd * gnb[0], y[5] * rstd * gnb[1]); o.w = pkh(y[6] * rstd * gnb[2], y[7] * rstd * gnb[3]);
    *(u32x4*)(F.MIX + (size_t)m * DM + AW + 8 * lane) = o;
}

#define SEL_COUNT(res, ni, PRED) do { int c_ = 0; \
    _Pragma("unroll") for (int i = 0; i < 16; ++i) c_ += (PRED(u[i], 64 * i + lane)) ? 1 : 0; \
    if ((ni) > 16) { _Pragma("unroll") for (int i = 16; i < 32; ++i) c_ += (PRED(u[i], 64 * i + lane)) ? 1 : 0; } \
    if ((ni) > 32) { _Pragma("unroll") for (int i = 32; i < 48; ++i) c_ += (PRED(u[i], 64 * i + lane)) ? 1 : 0; } \
    if ((ni) > 48) { _Pragma("unroll") for (int i = 48; i < 64; ++i) c_ += (PRED(u[i], 64 * i + lane)) ? 1 : 0; } \
    res = wave_sum_i(c_); } while (0)

__device__ __forceinline__ unsigned long long cmp_ge_mask(unsigned x, unsigned c) { unsigned long long m; asm("v_cmp_ge_u32_e64 %0, %1, %2" : "=s"(m) : "v"(x), "s"(c)); return m; }
__device__ __forceinline__ void addc_mask(int& acc, unsigned long long m) { unsigned long long co_; asm("v_addc_co_u32_e64 %0, %1, 0, %0, %2" : "+v"(acc), "=s"(co_) : "s"(m)); }
#define GE2_BLOCK8(a0, a1, base, cand) do { unsigned long long t0_, t1_, t2_, t3_, t4_, t5_, t6_, t7_; \
    asm("v_cmp_ge_u32_e64 %2, %10, %18\n\tv_cmp_ge_u32_e64 %3, %11, %18\n\tv_cmp_ge_u32_e64 %4, %12, %18\n\tv_cmp_ge_u32_e64 %5, %13, %18\n\t" \
        "v_cmp_ge_u32_e64 %6, %14, %18\n\tv_cmp_ge_u32_e64 %7, %15, %18\n\tv_cmp_ge_u32_e64 %8, %16, %18\n\tv_cmp_ge_u32_e64 %9, %17, %18\n\t" \
        "v_addc_co_u32_e64 %0, %2, 0, %0, %2\n\tv_addc_co_u32_e64 %1, %3, 0, %1, %3\n\tv_addc_co_u32_e64 %0, %4, 0, %0, %4\n\tv_addc_co_u32_e64 %1, %5, 0, %1, %5\n\t" \
        "v_addc_co_u32_e64 %0, %6, 0, %0, %6\n\tv_addc_co_u32_e64 %1, %7, 0, %1, %7\n\tv_addc_co_u32_e64 %0, %8, 0, %0, %8\n\tv_addc_co_u32_e64 %1, %9, 0, %1, %9" \
        : "+v"(a0), "+v"(a1), "=&s"(t0_), "=&s"(t1_), "=&s"(t2_), "=&s"(t3_), "=&s"(t4_), "=&s"(t5_), "=&s"(t6_), "=&s"(t7_) \
        : "v"(u[(base) + 0]), "v"(u[(base) + 1]), "v"(u[(base) + 2]), "v"(u[(base) + 3]), "v"(u[(base) + 4]), "v"(u[(base) + 5]), "v"(u[(base) + 6]), "v"(u[(base) + 7]), "s"(cand)); } while (0)
#define SEL_COUNT_GE2(res, ni, cand) do { int a0_ = 0, a1_ = 0; GE2_BLOCK8(a0_, a1_, 0, cand); GE2_BLOCK8(a0_, a1_, 8, cand); \
    if ((ni) > 16) { GE2_BLOCK8(a0_, a1_, 16, cand); GE2_BLOCK8(a0_, a1_, 24, cand); } \
    if ((ni) > 32) { GE2_BLOCK8(a0_, a1_, 32, cand); GE2_BLOCK8(a0_, a1_, 40, cand); } \
    if ((ni) > 48) { GE2_BLOCK8(a0_, a1_, 48, cand); GE2_BLOCK8(a0_, a1_, 56, cand); } \
    res = wave_sum_i(a0_ + a1_); } while (0)

#define GE3_BLOCK8(a0, a1, base, cm1) do { unsigned t0_, t1_, t2_, t3_, t4_, t5_, t6_, t7_; \
    asm("v_sub_u32_e64 %2, %10, %18 clamp\n\tv_sub_u32_e64 %3, %11, %18 clamp\n\tv_sub_u32_e64 %4, %12, %18 clamp\n\tv_sub_u32_e64 %5, %13, %18 clamp\n\t" \
        "v_sub_u32_e64 %6, %14, %18 clamp\n\tv_sub_u32_e64 %7, %15, %18 clamp\n\tv_sub_u32_e64 %8, %16, %18 clamp\n\tv_sub_u32_e64 %9, %17, %18 clamp\n\t" \
        "v_min_u32_e32 %2, 1, %2\n\tv_min_u32_e32 %3, 1, %3\n\tv_min_u32_e32 %4, 1, %4\n\tv_min_u32_e32 %5, 1, %5\n\t" \
        "v_min_u32_e32 %6, 1, %6\n\tv_min_u32_e32 %7, 1, %7\n\tv_min_u32_e32 %8, 1, %8\n\tv_min_u32_e32 %9, 1, %9\n\t" \
        "v_add3_u32 %0, %2, %3, %0\n\tv_add3_u32 %1, %4, %5, %1\n\tv_add3_u32 %0, %6, %7, %0\n\tv_add3_u32 %1, %8, %9, %1" \
        : "+v"(a0), "+v"(a1), "=&v"(t0_), "=&v"(t1_), "=&v"(t2_), "=&v"(t3_), "=&v"(t4_), "=&v"(t5_), "=&v"(t6_), "=&v"(t7_) \
        : "v"(u[(base) + 0]), "v"(u[(base) + 1]), "v"(u[(base) + 2]), "v"(u[(base) + 3]), "v"(u[(base) + 4]), "v"(u[(base) + 5]), "v"(u[(base) + 6]), "v"(u[(base) + 7]), "s"(cm1)); } while (0)
#define SEL_COUNT_GE3(res, ni, cand) do { int a0_ = 0, a1_ = 0; const unsigned cm1_ = (cand) - 1u; GE3_BLOCK8(a0_, a1_, 0, cm1_); GE3_BLOCK8(a0_, a1_, 8, cm1_); \
    if ((ni) > 16) { GE3_BLOCK8(a0_, a1_, 16, cm1_); GE3_BLOCK8(a0_, a1_, 24, cm1_); } \
    if ((ni) > 32) { GE3_BLOCK8(a0_, a1_, 32, cm1_); GE3_BLOCK8(a0_, a1_, 40, cm1_); } \
    if ((ni) > 48) { GE3_BLOCK8(a0_, a1_, 48, cm1_); GE3_BLOCK8(a0_, a1_, 56, cm1_); } \
    res = wave_sum_i(a0_ + a1_); } while (0)

__device__ __forceinline__ float bfly_max_16_32(float v) {
    auto r = __builtin_amdgcn_permlane16_swap(__float_as_uint(v), __float_as_uint(v), false, false); v = __builtin_fmaxf(__uint_as_float(r[0]), __uint_as_float(r[1]));
    auto q = __builtin_amdgcn_permlane32_swap(__float_as_uint(v), __float_as_uint(v), false, false); return __builtin_fmaxf(__uint_as_float(q[0]), __uint_as_float(q[1]));
}
__device__ __forceinline__ float bfly_sum_16_32(float v) {
    auto r = __builtin_amdgcn_permlane16_swap(__float_as_uint(v), __float_as_uint(v), false, false); v = __uint_as_float(r[0]) + __uint_as_float(r[1]);
    auto q = __builtin_amdgcn_permlane32_swap(__float_as_uint(v), __float_as_uint(v), false, false); return __uint_as_float(q[0]) + __uint_as_float(q[1]);
}
__device__ __forceinline__ unsigned wave_max_u(unsigned x) {
#define WMX_STEP(ctrl, rm, bc) do { const unsigned y_ = (unsigned)__builtin_amdgcn_update_dpp(0, (int)x, ctrl, rm, 0xf, bc); x = x > y_ ? x : y_; } while (0)
    WMX_STEP(0x111, 0xf, true); WMX_STEP(0x112, 0xf, true); WMX_STEP(0x114, 0xf, true); WMX_STEP(0x118, 0xf, true); WMX_STEP(0x142, 0xa, false); WMX_STEP(0x143, 0xc, false);
#undef WMX_STEP
    return (unsigned)__builtin_amdgcn_readlane((int)x, 63);
}
__device__ __forceinline__ int wave_prefix_incl(int x) {
    x += __builtin_amdgcn_update_dpp(0, x, 0x111, 0xf, 0xf, true);
    x += __builtin_amdgcn_update_dpp(0, x, 0x112, 0xf, 0xf, true);
    x += __builtin_amdgcn_update_dpp(0, x, 0x114, 0xf, 0xf, true);
    x += __builtin_amdgcn_update_dpp(0, x, 0x118, 0xf, 0xf, true);
    x += __builtin_amdgcn_update_dpp(0, x, 0x142, 0xa, 0xf, false);
    x += __builtin_amdgcn_update_dpp(0, x, 0x143, 0xc, 0xf, false);
    return x;
}

constexpr int VSTG_OFF = 131072;
constexpr int STASH_OFF = VSTG_OFF + 16384;
constexpr int WTAB_OFF = STASH_OFF + 4096;
constexpr int LIST_OFF = WTAB_OFF + 256;
__device__ __forceinline__ int sfx_find(int v, int need, int& ex, int& val) {
#if defined(SEL_SFX_OLD)
    const int lane_ = threadIdx.x & 63; int sfx_ = v;
#pragma unroll
    for (int o = 1; o < 64; o <<= 1) { const int tt = __shfl_down(sfx_, o); if (lane_ + o < 64) sfx_ += tt; }
    const int excl = sfx_ - v;
#else
    const int pin = wave_prefix_incl(v); const int total = __builtin_amdgcn_readlane(pin, 63);
    const int excl = total - pin;
#endif
    const bool hit = (excl < need) && (need <= excl + v);
    const unsigned long long m = __ballot(hit);
    const int Ls = m ? (int)__builtin_ctzll(m) : 0;
    ex = __builtin_amdgcn_readlane(excl, Ls); val = __builtin_amdgcn_readlane(v, Ls);
    return Ls;
}
__device__ __forceinline__ void wg_arrive(volatile LAS unsigned* cnt, int lane) { asm volatile("s_waitcnt lgkmcnt(0)" ::: "memory"); if (lane == 0) (void)__hip_atomic_fetch_add((LAS unsigned*)cnt, 1u, __ATOMIC_RELAXED, __HIP_MEMORY_SCOPE_WORKGROUP); }
__device__ __forceinline__ void wg_wait(volatile LAS unsigned* cnt, unsigned target) {
    while ((unsigned)__builtin_amdgcn_readfirstlane((int)__hip_atomic_load((LAS unsigned*)cnt, __ATOMIC_RELAXED, __HIP_MEMORY_SCOPE_WORKGROUP)) < target) __builtin_amdgcn_s_sleep(1);
    asm volatile("" ::: "memory");
}
__device__ __forceinline__ void sa_phase(Frame& F) {
    const int lane = F.lane, wave = F.wave;
    const int xcd = F.vcu >> 5, wloc = F.vcu & 31, b = 2 * xcd + (wloc >> 4), wl = wloc & 15;
    const size_t rowbase = (size_t)b * SEQ;
    LAS unsigned char* myreg = F.lds + RING_OFF + wave * 16384;
    LAS unsigned char* VT = F.lds + VSTG_OFF + wave * 2048;
    LAS float* SC = (LAS float*)(F.lds + RING_OFF);
    const f16x8 zero8 = {0, 0, 0, 0, 0, 0, 0, 0};
    f16x8 a[2][2]; f32x4 wv[2][2][2];
    LAS unsigned short* lprev = (LAS unsigned short*)(F.lds + LIST_OFF + wave * 512);
    int tprev = -1;
    const __amdgpu_buffer_rsrc_t rsK = __builtin_amdgcn_make_buffer_rsrc((void*)(F.K + rowbase * HD), 0, SEQ * HD * 2, 0x00020000);
    const __amdgpu_buffer_rsrc_t rsKI = __builtin_amdgcn_make_buffer_rsrc((void*)(F.KI + rowbase * ID), 0, SEQ * ID * 2, 0x00020000);
    const __amdgpu_buffer_rsrc_t rsV = __builtin_amdgcn_make_buffer_rsrc((void*)(F.V + rowbase * HD), 0, SEQ * HD * 2, 0x00020000);
    f16x8 bqn0 = {0, 0, 0, 0, 0, 0, 0, 0}, bqn1 = {0, 0, 0, 0, 0, 0, 0, 0};
    volatile LAS unsigned* cnt1 = F.MISC + 16; volatile LAS unsigned* cnt2 = F.MISC + 32;
    f16x8 pa_reg = zero8; float pw_reg = 0.f;
    const int rta = (wave >> 1) & 1, kca = wave & 1;
    LAS unsigned char* STASH = F.lds + STASH_OFF; LAS float* WTAB = (LAS float*)(F.lds + WTAB_OFF);
#define STASH_LOAD(T0) do { if (wave == 4) pw_reg = F.WI[(rowbase + (T0)) * IH + lane]; \
        if (wave < 4) pa_reg = *(const f16x8*)(F.QI + (rowbase + (T0) + 4 * rta + qa) * (IH * ID) + ahead * ID + 16 * kca + 8 * hi); } while (0)
#define STASH_STORE() do { if (wave == 4) WTAB[lane] = pw_reg; if (wave < 4) *(LAS f16x8*)(STASH + wave * 1024 + lane * 16) = pa_reg; } while (0)
#define KIX(g) ((int)lprev[16 * (g) + head_])
#define VIX(i) ((int)lprev[32 * ((i) >> 2) + 8 * ((i) & 3) + (ln_ >> 3)])
#define ATTN_BLOCK() do { if (tprev >= 0) { __builtin_amdgcn_s_setprio(1); \
        int ln_ = lane; asm volatile("" : "+v"(ln_));     \
        const int head_ = ln_ & 15, q4_ = ln_ >> 4; \
        const int t = tprev; const int cnt_sel = (t + 1) < TOPK ? (t + 1) : TOPK; \
        const f16x8 bq0 = bqn0, bq1 = bqn1; \
        f32x4 s[16]; \
        _Pragma("unroll") for (int qtr = 0; qtr < 4; ++qtr) {     \
            u32x4 kr[4][2]; \
            _Pragma("unroll") for (int g = 0; g < 4; ++g) \
                _Pragma("unroll") for (int rep = 0; rep < 2; ++rep) kr[g][rep] = __builtin_amdgcn_raw_buffer_load_b128(rsK, (int)lprev[16 * (4 * qtr + g) + 8 * rep + (ln_ >> 3)] * (HD * 2) + 16 * (ln_ & 7), 0, 0); \
            _Pragma("unroll") for (int g = 0; g < 4; ++g) { \
                _Pragma("unroll") for (int rep = 0; rep < 2; ++rep) { const int pl = 8 * rep + (ln_ >> 3), ch = ln_ & 7; *(LAS u32x4*)(VT + pl * 128 + 16 * (ch ^ ((pl >> 1) & 7))) = kr[g][rep]; } \
                const int r_ = ln_ & 15; \
                const f16x8 ak0 = *(const LAS f16x8*)(VT + r_ * 128 + 16 * (q4_ ^ ((r_ >> 1) & 7))), ak1 = *(const LAS f16x8*)(VT + r_ * 128 + 16 * ((q4_ + 4) ^ ((r_ >> 1) & 7))); \
                f32x4 c = {0.f, 0.f, 0.f, 0.f}; c = mfma16(ak0, bq0, c); c = mfma16(ak1, bq1, c); s[4 * qtr + g] = c; } \
        } \
        u32x4 vr[2][4]; \
        _Pragma("unroll") for (int cc = 0; cc < 2; ++cc) \
            _Pragma("unroll") for (int rep = 0; rep < 4; ++rep) vr[cc][rep] = __builtin_amdgcn_raw_buffer_load_b128(rsV, VIX(4 * cc + rep) * (HD * 2) + 16 * (ln_ & 7), 0, 0); \
        if (cnt_sel < TOPK) { const int thr2 = cnt_sel - 4 * q4_; \
            _Pragma("unroll") for (int g = 0; g < 16; ++g) \
                _Pragma("unroll") for (int e = 0; e < 4; ++e) if (16 * g + e >= thr2) s[g][e] = -INFINITY; \
        } \
        float mx = s[0][0]; \
        _Pragma("unroll") for (int g = 0; g < 16; ++g) \
            _Pragma("unroll") for (int e = 0; e < 4; ++e) mx = __builtin_fmaxf(mx, s[g][e]); \
        mx = bfly_max_16_32(mx); \
        float l = 0.f; \
        _Pragma("unroll") for (int g = 0; g < 16; ++g) \
            _Pragma("unroll") for (int e = 0; e < 4; ++e) { const float pv = __builtin_amdgcn_exp2f(s[g][e] - mx); s[g][e] = pv; l += pv; } \
        l = bfly_sum_16_32(l); \
        f32x4 o[4]; \
        _Pragma("unroll") for (int dt = 0; dt < 4; ++dt) o[dt] = (f32x4){0.f, 0.f, 0.f, 0.f}; \
        _Pragma("unroll") for (int c = 0; c < 8; ++c) { \
            _Pragma("unroll") for (int rd = 0; rd < 2; ++rd) { \
                _Pragma("unroll") for (int r2 = 0; r2 < 2; ++r2) { const int pl = 8 * r2 + (ln_ >> 3), ch = ln_ & 7; \
                    *(LAS u32x4*)(VT + pl * 128 + 16 * (ch ^ (2 * ((pl >> 1) & 3)))) = vr[c & 1][2 * rd + r2]; } \
                v4i16_t tr[4]; \
                _Pragma("unroll") for (int dt = 0; dt < 4; ++dt) { const int R = 4 * q4_ + ((ln_ & 15) >> 2), pp = ln_ & 3, chunk = 2 * dt + (pp >> 1); \
                    tr[dt] = __builtin_amdgcn_ds_read_tr16_b64_v4i16((LAS v4i16_t*)(VT + R * 128 + 16 * (chunk ^ (2 * ((R >> 1) & 3))) + 8 * (pp & 1))); } \
                const f32x4 pa = s[2 * c + rd]; u32x2 w; w.x = pkh(pa[0], pa[1]); w.y = pkh(pa[2], pa[3]); const f16x4 bp = __builtin_bit_cast(f16x4, w); \
                _Pragma("unroll") for (int dt = 0; dt < 4; ++dt) o[dt] = __builtin_amdgcn_mfma_f32_16x16x16f16(__builtin_bit_cast(f16x4, tr[dt]), bp, o[dt], 0, 0, 0); \
            } \
            if (c < 6) { \
                _Pragma("unroll") for (int rep = 0; rep < 4; ++rep) vr[c & 1][rep] = __builtin_amdgcn_raw_buffer_load_b128(rsV, VIX(4 * (c + 2) + rep) * (HD * 2) + 16 * (ln_ & 7), 0, 0); \
            } \
        } \
        const float inv_l = 1.0f / l; float ss = 0.f; \
        _Pragma("unroll") for (int dt = 0; dt < 4; ++dt) { o[dt] = o[dt] * inv_l; ss += (o[dt][0] * o[dt][0] + o[dt][1] * o[dt][1]) + (o[dt][2] * o[dt][2] + o[dt][3] * o[dt][3]); } \
        ss = bfly_sum_16_32(ss); \
        const float rstd = 1.0f / sqrtf(ss * (1.f / 64.f) + EPS); \
        if (head_ < NH) { \
            _Pragma("unroll") for (int dt = 0; dt < 4; ++dt) { const int col = head_ * HD + 16 * dt + 4 * q4_; const f32x4 gn = *(const f32x4*)(F.attn_g + col); \
                const f32x4 y = o[dt] * rstd * gn; u32x2 w; w.x = pkh(y[0], y[1]); w.y = pkh(y[2], y[3]); \
                *(u32x2*)(F.MIX + (rowbase + t) * DM + col) = w; } \
        } __builtin_amdgcn_s_setprio(0); } } while (0)

    { const int c31 = lane & 31, hi = lane >> 5, g_ = c31 >> 3, hp_ = (c31 >> 2) & 1, jj_ = c31 & 3, qa = 2 * hp_ + (g_ >> 1), ahead = 4 * (g_ & 1) + jj_;
      STASH_LOAD(8 * wl); STASH_STORE(); }
    asm volatile("s_waitcnt lgkmcnt(0)\n\ts_barrier" ::: "memory");
    for (int it = 0; it < 32; ++it) {
        const int p = wl + 16 * (it >> 1); const int qg = (it & 1) ? 511 - p : p;
        const int t0 = 8 * qg;
        int lr_ = lane; asm volatile("" : "+v"(lr_));
        const int c31 = lr_ & 31, hi = lr_ >> 5, g_ = c31 >> 3, hp_ = (c31 >> 2) & 1, jj_ = c31 & 3, qa = 2 * hp_ + (g_ >> 1), ahead = 4 * (g_ & 1) + jj_;
        {
            const int ntiles = (t0 + 8 + 31) >> 5;
            if (it > 0) wg_wait(cnt2, 8u * (unsigned)it);
#pragma unroll
            for (int rt = 0; rt < 2; ++rt) {
#pragma unroll
                for (int kc = 0; kc < 2; ++kc) a[rt][kc] = *(const LAS f16x8*)(STASH + (rt * 2 + kc) * 1024 + lane * 16);
#pragma unroll
                for (int qq = 0; qq < 2; ++qq)
#pragma unroll
                    for (int h = 0; h < 2; ++h) wv[rt][qq][h] = *(const LAS f32x4*)(WTAB + (4 * rt + 2 * hi + qq) * 8 + 4 * h); }
            volatile LAS unsigned* tcnt = F.MISC + 48 + 4 * (it & 1);
            for (;;) {
                unsigned g0_ = 0u; if (lane == 0) g0_ = __hip_atomic_fetch_add((LAS unsigned*)tcnt, 4u, __ATOMIC_RELAXED, __HIP_MEMORY_SCOPE_WORKGROUP);
                const int k0 = __builtin_amdgcn_readfirstlane((int)g0_);
#if defined(SEL16)
                if (k0 >= ((ntiles + 3) & ~3)) break;
#pragma unroll
                for (int i = 0; i < 4; ++i) { const int kt = k0 + i;
                    if (kt >= ntiles) {
#pragma unroll
                        for (int rq = 0; rq < 4; ++rq) ((LAS unsigned short*)SC)[((rq >> 1) * 4 + 2 * hi + (rq & 1)) * 8192 + 32 * kt + c31] = (unsigned short)0; } }
                if (k0 >= ntiles) continue;
#else
                if (k0 >= ntiles) break;
#endif
                f16x8 bt[4][2];
#pragma unroll
                for (int i = 0; i < 4; ++i) { int kt = k0 + i; kt = kt < ntiles ? kt : ntiles - 1;
                    bt[i][0] = __builtin_bit_cast(f16x8, __builtin_amdgcn_raw_buffer_load_b128(rsKI, c31 * (ID * 2) + 16 * hi, kt * (32 * ID * 2), 0));
                    bt[i][1] = __builtin_bit_cast(f16x8, __builtin_amdgcn_raw_buffer_load_b128(rsKI, c31 * (ID * 2) + 16 * hi + 32, kt * (32 * ID * 2), 0)); }
#pragma unroll
                for (int i = 0; i < 4; ++i) { const int kt = k0 + i;
                    if (kt < ntiles) {
#pragma unroll
                        for (int rt = 0; rt < 2; ++rt) {
                            f32x16 c = {0.f, 0.f, 0.f, 0.f, 0.f, 0.f, 0.f, 0.f, 0.f, 0.f, 0.f, 0.f, 0.f, 0.f, 0.f, 0.f};
                            c = mfma32(a[rt][0], bt[i][0], c); c = mfma32(a[rt][1], bt[i][1], c);
#pragma unroll
                            for (int qq = 0; qq < 2; ++qq) { float s = 0.f;
#pragma unroll
                                for (int hd = 0; hd < 8; ++hd) { const float cf = c[8 * qq + hd]; const int ci = __float_as_int(cf); s = __builtin_fmaf(__int_as_float(ci > 0 ? ci : 0), wv[rt][qq][hd >> 2][hd & 3], s); }
#if defined(SEL16)
                                int qv_ = (int)__builtin_fmaf(s, 2048.0f, 32768.5f); qv_ = qv_ < 1 ? 1 : (qv_ > 65535 ? 65535 : qv_);
                                if (kt == ntiles - 1 && 32 * kt + c31 > t0 + 4 * rt + 2 * hi + qq) qv_ = 0;
                                ((LAS unsigned short*)SC)[(4 * rt + 2 * hi + qq) * 8192 + 32 * kt + c31] = (unsigned short)qv_; }
#else
                                SC[(4 * rt + 2 * hi + qq) * 4096 + 32 * kt + c31] = s; }
#endif
                        }
                    }
                }
            }
        }
        wg_arrive(cnt1, lane);
        if (it + 1 < 32) { const int p2 = wl + 16 * ((it + 1) >> 1); const int qg2 = ((it + 1) & 1) ? 511 - p2 : p2; STASH_LOAD(8 * qg2); }
        if (wave >= 4) ATTN_BLOCK();
        const int tcur = t0 + wave;
        while ((unsigned)__builtin_amdgcn_readfirstlane((int)__hip_atomic_load((LAS unsigned*)cnt1, __ATOMIC_RELAXED, __HIP_MEMORY_SCOPE_WORKGROUP)) < 8u * (unsigned)(it + 1)) {
            unsigned g1_ = 0u; if (lane == 0) g1_ = __hip_atomic_fetch_add((LAS unsigned*)(F.MISC + 56), 1u, __ATOMIC_RELAXED, __HIP_MEMORY_SCOPE_WORKGROUP);
            const int cr = __builtin_amdgcn_readfirstlane((int)g1_);
            if (cr < 256) conv_row_one(F, F.vcu * 256 + cr, lane); else __builtin_amdgcn_s_sleep(1);
        }
        asm volatile("" ::: "memory");
        STASH_STORE();
        if (wave == 0 && lane == 0) F.MISC[48 + 4 * ((it + 1) & 1)] = 0u;
        LAS unsigned short* IDX = (LAS unsigned short*)(F.lds + LIST_OFF + ((it & 1) * 8 + wave) * 512);
#if defined(SEL16)
        {
            const int n = tcur + 1, nr = (t0 + 8 + 127) >> 7;
            unsigned x[32];
            { const LAS unsigned* S = (const LAS unsigned*)myreg;
#pragma unroll
              for (int i = 0; i < 32; ++i) { const unsigned v_ = S[64 * i + lane]; x[i] = (i < nr) ? v_ : 0u; } }
            asm volatile("" :: "v"(x[0]), "v"(x[7]), "v"(x[15]), "v"(x[31]) : "memory");
            wg_arrive(cnt2, lane);
#define P16_BLOCK8(a0, a1, base, cs) do { unsigned t0_, t1_, t2_, t3_, t4_, t5_, t6_, t7_; \
    asm("v_pk_sub_u16 %2, %10, %18 clamp\n\tv_pk_sub_u16 %3, %11, %18 clamp\n\tv_pk_sub_u16 %4, %12, %18 clamp\n\tv_pk_sub_u16 %5, %13, %18 clamp\n\t" \
        "v_pk_sub_u16 %6, %14, %18 clamp\n\tv_pk_sub_u16 %7, %15, %18 clamp\n\tv_pk_sub_u16 %8, %16, %18 clamp\n\tv_pk_sub_u16 %9, %17, %18 clamp\n\t" \
        "v_pk_min_u16 %2, %2, %19\n\tv_pk_min_u16 %3, %3, %19\n\tv_pk_min_u16 %4, %4, %19\n\tv_pk_min_u16 %5, %5, %19\n\t" \
        "v_pk_min_u16 %6, %6, %19\n\tv_pk_min_u16 %7, %7, %19\n\tv_pk_min_u16 %8, %8, %19\n\tv_pk_min_u16 %9, %9, %19\n\t" \
        "v_pk_add_u16 %0, %0, %2\n\tv_pk_add_u16 %1, %1, %3\n\tv_pk_add_u16 %0, %0, %4\n\tv_pk_add_u16 %1, %1, %5\n\t" \
        "v_pk_add_u16 %0, %0, %6\n\tv_pk_add_u16 %1, %1, %7\n\tv_pk_add_u16 %0, %0, %8\n\tv_pk_add_u16 %1, %1, %9" \
        : "+v"(a0), "+v"(a1), "=&v"(t0_), "=&v"(t1_), "=&v"(t2_), "=&v"(t3_), "=&v"(t4_), "=&v"(t5_), "=&v"(t6_), "=&v"(t7_) \
        : "v"(x[(base) + 0]), "v"(x[(base) + 1]), "v"(x[(base) + 2]), "v"(x[(base) + 3]), "v"(x[(base) + 4]), "v"(x[(base) + 5]), "v"(x[(base) + 6]), "v"(x[(base) + 7]), "s"(cs), "v"(one2)); } while (0)
#define P16_COUNT(res, cand) do { unsigned a0_ = 0u, a1_ = 0u; const unsigned cs_ = ((cand) - 1u) * 0x00010001u; \
    P16_BLOCK8(a0_, a1_, 0, cs_); if (nr > 8) P16_BLOCK8(a0_, a1_, 8, cs_); if (nr > 16) P16_BLOCK8(a0_, a1_, 16, cs_); if (nr > 24) P16_BLOCK8(a0_, a1_, 24, cs_); \
    const unsigned aa_ = a0_ + a1_; res = __builtin_amdgcn_readlane(wave_prefix_incl((int)((aa_ & 0xffffu) + (aa_ >> 16))), 63); } while (0)
            const unsigned one2 = 0x00010001u;
            unsigned T16 = 0u; int r = 0;
            if (n > TOPK) {
                unsigned mp = x[0];
#pragma unroll
                for (int i = 1; i < 32; ++i) asm("v_pk_max_u16 %0, %0, %1" : "+v"(mp) : "v"(x[i]));
                const unsigned mx = wave_max_u((mp & 0xffffu) > (mp >> 16) ? (mp & 0xffffu) : (mp >> 16));
                unsigned Tacc = 0u; bool exact = false;
                for (int bit = 31 - __builtin_clz(mx); bit >= 0; --bit) {
                    const unsigned cand = Tacc | (1u << bit);
                    if (cand <= mx) { int c; P16_COUNT(c, cand);
                        if (c >= TOPK) { Tacc = cand; if (c == TOPK) { exact = true; break; } } }
                }
                if (exact) { T16 = Tacc - 1u; r = 0; }
                else { T16 = Tacc; int cgt = 0; if (T16 < 65535u) P16_COUNT(cgt, T16 + 1u); r = TOPK - cgt; }
            }
            unsigned W0 = 0u, W1 = 0u, E0 = 0u, E1 = 0u;
            { const unsigned ts_ = T16 * 0x00010001u;
#define P16_FLAGS(dst, i, cs) do { unsigned g_; asm("v_pk_sub_u16 %0, %1, %2 clamp\n\tv_pk_min_u16 %0, %0, %3" : "=&v"(g_) : "v"(x[i]), "s"(cs), "v"(one2)); dst = (dst << 2) | ((g_ & 1u) << 1) | (g_ >> 16); } while (0)
#pragma unroll
              for (int i = 0; i < 16; ++i) P16_FLAGS(W0, i, ts_);
#pragma unroll
              for (int i = 16; i < 32; ++i) P16_FLAGS(W1, i, ts_);
              if (r > 0) {
                  const unsigned es_ = (T16 - 1u) * 0x00010001u;
#pragma unroll
                  for (int i = 0; i < 16; ++i) P16_FLAGS(E0, i, es_);
#pragma unroll
                  for (int i = 16; i < 32; ++i) P16_FLAGS(E1, i, es_);
                  E0 &= ~W0; E1 &= ~W1;
                  for (int pick = 0; pick < r; ++pick) {
                      unsigned kmine = 0xffffu, pb = 0u; int wsel = 0;
                      if (E0) { const int p_ = __builtin_clz(E0); kmine = (unsigned)(128 * (p_ >> 1) + 2 * lane + (p_ & 1)); pb = 0x80000000u >> p_; wsel = 0; }
                      else if (E1) { const int p_ = __builtin_clz(E1); kmine = (unsigned)(128 * (16 + (p_ >> 1)) + 2 * lane + (p_ & 1)); pb = 0x80000000u >> p_; wsel = 1; }
                      const unsigned kmin = ~wave_max_u(~kmine);
                      if (kmine == kmin && kmin != 0xffffu) { if (wsel == 0) { E0 &= ~pb; W0 |= pb; } else { E1 &= ~pb; W1 |= pb; } }
                  }
              }
#undef P16_FLAGS
            }
            const int mycnt = __builtin_popcount(W0) + __builtin_popcount(W1);
            const int incl = wave_prefix_incl(mycnt);
            int pos = incl - mycnt;
            while (__ballot((W0 | W1) != 0u)) {
                if (W0) { const int p_ = __builtin_clz(W0); IDX[pos] = (unsigned short)(128 * (p_ >> 1) + 2 * lane + (p_ & 1)); ++pos; W0 &= ~(0x80000000u >> p_); }
                else if (W1) { const int p_ = __builtin_clz(W1); IDX[pos] = (unsigned short)(128 * (16 + (p_ >> 1)) + 2 * lane + (p_ & 1)); ++pos; W1 &= ~(0x80000000u >> p_); }
            }
            const int total = __builtin_amdgcn_readlane(incl, 63);
            for (int s = total + lane; s < TOPK; s += 64) IDX[s] = 0;
#undef P16_COUNT
#undef P16_BLOCK8
        }
#else
        {
            const int n = tcur + 1, ni = (n + 63) >> 6, thr = n - lane;
            unsigned u[64];
            { const LAS unsigned* S = (const LAS unsigned*)myreg;
#define ULOAD(i) do { const unsigned bits = S[64 * (i) + lane]; const unsigned ord = bits ^ ((unsigned)((int)bits >> 31) | 0x80000000u); u[i] = (64 * (i) < thr) ? ord : 0u; } while (0)
#pragma unroll
              for (int i = 0; i < 16; ++i) ULOAD(i);
              if (ni > 16) {
#pragma unroll
                  for (int i = 16; i < 32; ++i) ULOAD(i); }
              else {
#pragma unroll
                  for (int i = 16; i < 32; ++i) u[i] = 0u; }
              if (ni > 32) {
#pragma unroll
                  for (int i = 32; i < 48; ++i) ULOAD(i); }
              else {
#pragma unroll
                  for (int i = 32; i < 48; ++i) u[i] = 0u; }
              if (ni > 48) {
#pragma unroll
                  for (int i = 48; i < 64; ++i) ULOAD(i); }
              else {
#pragma unroll
                  for (int i = 48; i < 64; ++i) u[i] = 0u; }
#undef ULOAD
            }
            asm volatile("" :: "v"(u[0]), "v"(u[15]), "v"(u[31]), "v"(u[63]) : "memory");
#if !defined(SEL_RADIX)
            wg_arrive(cnt2, lane);
#endif
            unsigned T = 0u; int kb = 0;
#if defined(SEL_RADIX)
            if (n > TOPK) {
                unsigned prefix = 0u; int need = TOPK; bool done = false;
                for (int L = 0; L < 3 && !done; ++L) {
                    const int sh = (L == 0) ? 21 : (L == 1) ? 10 : 0, bits_ = (L == 2) ? 10 : 11, hsh = sh + bits_;
                    const int bpl = (L == 2) ? 16 : 32;
                    LDS_WAIT();
#pragma unroll
                    for (int k = 0; k < 8; ++k) *(LAS u32x4*)(myreg + k * 1024 + lane * 16) = (u32x4){0u, 0u, 0u, 0u};
                    if (L == 0) {
#define HADD0(i) (void)__hip_atomic_fetch_add((LAS unsigned*)(myreg + ((u[i] >> 19) & 0x1FFCu)), 1u, __ATOMIC_RELAXED, __HIP_MEMORY_SCOPE_WORKGROUP)
#pragma unroll
                        for (int i = 0; i < 16; ++i) HADD0(i);
                        if (ni > 16) {
#pragma unroll
                            for (int i = 16; i < 32; ++i) HADD0(i); }
                        if (ni > 32) {
#pragma unroll
                            for (int i = 32; i < 48; ++i) HADD0(i); }
                        if (ni > 48) {
#pragma unroll
                            for (int i = 48; i < 64; ++i) HADD0(i); }
#undef HADD0
                    } else {
#define HADD(i) do { const unsigned x_ = u[i]; if ((x_ >> hsh) == prefix) \
                        (void)__hip_atomic_fetch_add((LAS unsigned*)(myreg + (__builtin_amdgcn_ubfe(x_, sh, bits_) << 2)), 1u, __ATOMIC_RELAXED, __HIP_MEMORY_SCOPE_WORKGROUP); } while (0)
#pragma unroll
                        for (int i = 0; i < 16; ++i) HADD(i);
                        if (ni > 16) {
#pragma unroll
                            for (int i = 16; i < 32; ++i) HADD(i); }
                        if (ni > 32) {
#pragma unroll
                            for (int i = 32; i < 48; ++i) HADD(i); }
                        if (ni > 48) {
#pragma unroll
                            for (int i = 48; i < 64; ++i) HADD(i); }
#undef HADD
                    }
                    LDS_WAIT();
                    int mysum = 0;
                    if (L == 2) {
#pragma unroll
                        for (int k = 0; k < 4; ++k) { const u32x4 h4 = *(const LAS u32x4*)(myreg + lane * 64 + k * 16); mysum += (int)(h4.x + h4.y + h4.z + h4.w); }
                    } else {
#pragma unroll
                        for (int k = 0; k < 8; ++k) { const u32x4 h4 = *(const LAS u32x4*)(myreg + lane * 128 + k * 16); mysum += (int)(h4.x + h4.y + h4.z + h4.w); }
                    }
                    int ex1, v1; const int L1 = sfx_find(mysum, need, ex1, v1);
                    const int hv = (lane < bpl) ? (int)((LAS unsigned*)myreg)[L1 * bpl + lane] : 0;
                    int ex2, v2; const int j2 = sfx_find(hv, need - ex1, ex2, v2);
                    const unsigned bin = (unsigned)(L1 * bpl + j2);
                    const int nn = need - ex1 - ex2;
                    prefix = (prefix << bits_) | bin; need = nn;
                    if (v2 == nn) { T = (prefix << sh) - 1u; kb = 0; done = true; }
                }
                if (!done) {
                    T = prefix; const int r = need; int kacc = 0;
                    for (int bit = 12; bit >= 0; --bit) { const int kc = kacc | (1 << bit); int c;
#define P_EQK(x, k) ((x) == T && (k) < kc)
                        SEL_COUNT(c, ni, P_EQK);
#undef P_EQK
                        if (c <= r) kacc = kc; }
                    kb = kacc;
                }
            }
            wg_arrive(cnt2, lane);
#else
            if (n > TOPK) {
                unsigned mxl = u[0];
#pragma unroll
                for (int i = 1; i < 64; ++i) mxl = mxl > u[i] ? mxl : u[i];
                const unsigned mx = wave_max_u(mxl);
                unsigned Tacc = 0u; bool exact = false;
                for (int bit = 31 - __builtin_clz(mx); bit >= 0; --bit) {
                    const unsigned cand = Tacc | (1u << bit);
                    if (cand <= mx) {
                        int a0_ = 0, a1_ = 0; const unsigned cm1_ = cand - 1u;
                        GE3_BLOCK8(a0_, a1_, 0, cm1_); GE3_BLOCK8(a0_, a1_, 8, cm1_);
                        if (ni > 16) { GE3_BLOCK8(a0_, a1_, 16, cm1_); GE3_BLOCK8(a0_, a1_, 24, cm1_); }
                        if (ni > 32) { GE3_BLOCK8(a0_, a1_, 32, cm1_); GE3_BLOCK8(a0_, a1_, 40, cm1_); }
                        if (ni > 48) { GE3_BLOCK8(a0_, a1_, 48, cm1_); GE3_BLOCK8(a0_, a1_, 56, cm1_); }
                        const int c = __builtin_amdgcn_readlane(wave_prefix_incl(a0_ + a1_), 63);
                        if (c >= TOPK) { Tacc = cand; if (c == TOPK) { exact = true; break; } }
                    }
                }
                if (exact) { T = Tacc - 1u; kb = 0; }
                else {
                    T = Tacc; int cgt;
#define P_GT(x, k) ((x) > T)
                    SEL_COUNT(cgt, ni, P_GT);
#undef P_GT
                    const int r = TOPK - cgt; int kacc = 0;
                    for (int bit = 12; bit >= 0; --bit) { const int kc = kacc | (1 << bit); int c;
#define P_EQK(x, k) ((x) == T && (k) < kc)
                        SEL_COUNT(c, ni, P_EQK);
#undef P_EQK
                        if (c <= r) kacc = kc; }
                    kb = kacc;
                }
            }
#endif
            unsigned mlo = 0u, mhi = 0u;
#pragma unroll
            for (int i = 0; i < 32; ++i) mlo = mlo + mlo + ((u[i] > T) ? 1u : 0u);
#pragma unroll
            for (int i = 32; i < 64; ++i) mhi = mhi + mhi + ((u[i] > T) ? 1u : 0u);
            if (kb > 0) {
                unsigned elo = 0u, ehi = 0u;
#pragma unroll
                for (int i = 0; i < 32; ++i) elo = elo + elo + ((u[i] == T && (64 * i + lane) < kb) ? 1u : 0u);
#pragma unroll
                for (int i = 32; i < 64; ++i) ehi = ehi + ehi + ((u[i] == T && (64 * i + lane) < kb) ? 1u : 0u);
                mlo |= elo; mhi |= ehi;
            }
            const int mycnt = __builtin_popcount(mlo) + __builtin_popcount(mhi);
            const int incl = wave_prefix_incl(mycnt);
            int pos = incl - mycnt;
            while (__ballot((mlo | mhi) != 0u)) {
                if (mlo) { const int i = __builtin_clz(mlo); IDX[pos] = (unsigned short)(64 * i + lane); ++pos; mlo &= ~(0x80000000u >> i); }
                else if (mhi) { const int i = __builtin_clz(mhi); IDX[pos] = (unsigned short)(64 * (32 + i) + lane); ++pos; mhi &= ~(0x80000000u >> i); }
            }
            const int total = __builtin_amdgcn_readlane(incl, 63);
            for (int s = total + lane; s < TOPK; s += 64) IDX[s] = 0;
        }
#endif
        if (wave < 4) ATTN_BLOCK();
        tprev = tcur; lprev = IDX;
        { const int hd_ = lr_ & 15, qq4_ = lr_ >> 4; if (hd_ < NH) { const f16_t* qp = F.Q + (rowbase + tcur) * AW + hd_ * HD + 8 * qq4_; bqn0 = *(const f16x8*)qp; bqn1 = *(const f16x8*)(qp + 32); } }
    }
    ATTN_BLOCK();
    for (;;) {
        unsigned g1_ = 0u; if (lane == 0) g1_ = __hip_atomic_fetch_add((LAS unsigned*)(F.MISC + 56), 1u, __ATOMIC_RELAXED, __HIP_MEMORY_SCOPE_WORKGROUP);
        const int cr = __builtin_amdgcn_readfirstlane((int)g1_);
        if (cr >= 256) break;
        conv_row_one(F, F.vcu * 256 + cr, lane);
    }
#undef ATTN_BLOCK
#undef KIX
#undef VIX
#undef STASH_LOAD
#undef STASH_STORE
}

#ifndef MK_N_LAUNCHES
#define MK_N_LAUNCHES 1
#endif
constexpr int N_PHASES = 9;
constexpr int N_LAUNCHES = MK_N_LAUNCHES;
struct Args { const float* in[16]; float* out; unsigned char* ws; int ph_lo, ph_hi; };
static_assert(sizeof(Args) == 16 * 8 + 8 + 8 + 8, "Args has no padding");

__global__ void __launch_bounds__(NWAVES * 64, 2) hymba_fwd(Args args) {
    extern __shared__ __attribute__((aligned(16))) unsigned char lds[];
    Frame F;
    F.lds = (LAS unsigned char*)lds;
    F.MISC = (volatile LAS unsigned*)(F.lds + MISC_OFF);
    F.tid = threadIdx.x; F.lane = F.tid & 63; F.wave = __builtin_amdgcn_readfirstlane(F.tid >> 6);
    F.G = gridDim.x; { const int bx = blockIdx.x; F.vcu = (F.G % 8 == 0) ? (bx % 8) * (F.G / 8) + bx / 8 : bx; }
    unsigned char* ws = args.ws;
    F.ctl = (unsigned*)(ws + WS_CTL);
    F.x = args.in[0]; F.c = args.in[1]; F.w_ada = args.in[2]; F.b_ada = args.in[3]; F.w_in = args.in[4]; F.conv_w = args.in[5]; F.attn_g = args.in[6]; F.conv_g = args.in[7];
    F.w_out = args.in[8]; F.ln1_g = args.in[9]; F.ln1_b = args.in[10]; F.w_gate = args.in[11]; F.w_up = args.in[12]; F.w_down = args.in[13]; F.ln2_g = args.in[14]; F.ln2_b = args.in[15];
    F.out = args.out;
    F.MODP = (float*)(ws + WS_MODP); F.MOD = (float*)(ws + WS_MOD); F.ROPE = (float*)(ws + WS_ROPE); F.WI = (float*)(ws + WS_WI); F.X1H = (f16_t*)(ws + WS_X1); F.YH = (f16_t*)(ws + WS_X1 + 128 * MiB);
    F.WIN = (f16_t*)(ws + WS_WIN); F.WOUT = (f16_t*)(ws + WS_WOUT); F.WGU = (f16_t*)(ws + WS_WGU); F.WDN = (f16_t*)(ws + WS_WDN); F.XN = (f16_t*)(ws + WS_XN);
    F.Q = (f16_t*)(ws + WS_Q); F.K = (f16_t*)(ws + WS_K); F.V = (f16_t*)(ws + WS_V); F.QI = (f16_t*)(ws + WS_QI); F.KI = (f16_t*)(ws + WS_KI);
    F.GB = (f16_t*)(ws + WS_GB); F.U = (f16_t*)(ws + WS_U); F.MIX = (f16_t*)(ws + WS_MIX); F.H = (f16_t*)(ws + WS_H);
    for (int u = F.tid; u < (LDS_BYTES - LDSCTL_OFF) / 4; u += NWAVES * 64) ((LAS unsigned*)(F.lds + LDSCTL_OFF))[u] = 0u;
    __syncthreads();
    XcdBarrier bar; bar.bar = (unsigned*)(F.ctl + CW_BAR); bar.x = 0; bar.st = nullptr;
    if (N_LAUNCHES == 1) bar = xcd_barrier_post((unsigned*)(F.ctl + CW_BAR), F.MISC + 8);
    const int lo = args.ph_lo, hi = args.ph_hi;
#define IN(k) (lo <= (k) && (k) < hi)
#define SEAM(k) do { if (IN(k) && IN((k) + 1)) xcd_barrier(bar); } while (0)

    if (IN(0)) { p0_prologue(F); } SEAM(0);
    if (IN(1)) { p1_modulate(F); } SEAM(1);
    if (IN(2)) {
        pg8::Gemm g{F.XN, F.WIN, MTOK, NIN, DM}; pg8::StaticOrder S; S.init(MTOK, NIN, F.G, (int)blockIdx.x);
        pg8::EpiInProj E{F.Q, F.K, F.V, F.QI, F.KI, F.GB, F.U, F.WI, F.ROPE};
        pg8::gemm_phase<pg8::EpiInProj, pg8::StaticOrder, true, true>(F.lds + RING_OFF, g, S, E);
    } SEAM(2);
    if (IN(3)) {
        if (F.G == 256) sa_phase(F);
        else conv_rows(F);
    } SEAM(3);
    if (IN(4)) {
        pg8::Gemm g{F.MIX, F.WOUT, MTOK, DM, DM}; pg8::StaticOrder S; S.init(MTOK, DM, F.G, (int)blockIdx.x);
        pg8::EpiResGate<false> E{F.x, F.YH, F.MOD + 2 * DM};
        pg8::gemm_phase<pg8::EpiResGate<false>, pg8::StaticOrder, true, true>(F.lds + RING_OFF, g, S, E);
    } SEAM(4);
    if (IN(5)) { ln_rows<0>(F, F.YH, F.ln1_g, F.ln1_b); } SEAM(5);
    if (IN(6)) {
        pg8::Gemm g{F.XN, F.WGU, MTOK, NGU, DM}; pg8::StaticOrder S; S.init(MTOK, NGU, F.G, (int)blockIdx.x);
        pg8::EpiSwiGLU E{F.H};
        pg8::gemm_phase<pg8::EpiSwiGLU, pg8::StaticOrder, true, true, FFN_BF>(F.lds + RING_OFF, g, S, E);
    } SEAM(6);
    if (IN(7)) {
        pg8::Gemm g{F.H, F.WDN, MTOK, DM, DFF}; pg8::StaticOrder S; S.init(MTOK, DM, F.G, (int)blockIdx.x);
        pg8::EpiResGate<true> E{F.X1H, F.YH, F.MOD + 5 * DM};
        pg8::gemm_phase<pg8::EpiResGate<true>, pg8::StaticOrder, true, true, FFN_BF>(F.lds + RING_OFF, g, S, E);
    } SEAM(7);
    if (IN(8)) { ln_rows<1>(F, F.YH, F.ln2_g, F.ln2_b); }
#undef IN
#undef SEAM
}

extern "C" void kernel_launch(void* const* d_in, const int* in_sizes, int n_in, void* d_out, int out_size, void* d_ws, size_t ws_size, hipStream_t stream) {
    static int grid = 0;
    if (grid == 0) {
        if (n_in != 16 || in_sizes[0] != MTOK * DM || out_size != MTOK * DM || ws_size < WS_END) { fprintf(stderr, "kernel_launch: unexpected shapes (n_in %d, in0 %d, out %d, ws %zu)\n", n_in, n_in > 0 ? in_sizes[0] : -1, out_size, ws_size); grid = -1; return; }
        int dev = 0, cus = 0, per_cu = 0;
        if (hipGetDevice(&dev) != hipSuccess || hipDeviceGetAttribute(&cus, hipDeviceAttributeMultiprocessorCount, dev) != hipSuccess) { fprintf(stderr, "kernel_launch: device query failed\n"); grid = -1; return; }
        if (hipFuncSetAttribute((const void*)hymba_fwd, hipFuncAttributeMaxDynamicSharedMemorySize, LDS_BYTES) != hipSuccess) { fprintf(stderr, "kernel_launch: hipFuncSetAttribute failed\n"); grid = -1; return; }
        if (hipOccupancyMaxActiveBlocksPerMultiprocessor(&per_cu, (const void*)hymba_fwd, NWAVES * 64, LDS_BYTES) != hipSuccess || per_cu < 1) { fprintf(stderr, "kernel_launch: occupancy query reports %d workgroups per CU\n", per_cu); per_cu = 1; }
        (void)hipGetLastError();
        grid = cus;
        if (grid != 256) fprintf(stderr, "kernel_launch: %d CUs; the attention phase needs 256\n", grid);
    }
    if (grid < 0) return;
    if (hipMemsetAsync((char*)d_ws + WS_CTL, 0, CTL_ZERO_BYTES, stream) != hipSuccess) { fprintf(stderr, "kernel_launch: memset failed\n"); return; }
    Args a{};
    for (int i = 0; i < 16; ++i) a.in[i] = (const float*)d_in[i];
    a.out = (float*)d_out; a.ws = (unsigned char*)d_ws;
    for (int li = 0; li < N_LAUNCHES; ++li) {
        a.ph_lo = (N_LAUNCHES == 1) ? 0 : li; a.ph_hi = (N_LAUNCHES == 1) ? N_PHASES : li + 1;
        hipLaunchKernelGGL(hymba_fwd, dim3(grid), dim3(NWAVES * 64), LDS_BYTES, stream, a);
#if defined(REP_MASK)
        if (N_LAUNCHES != 1 && (((REP_MASK) >> li) & 1)) hipLaunchKernelGGL(hymba_fwd, dim3(grid), dim3(NWAVES * 64), LDS_BYTES, stream, a);
#endif
        const hipError_t le = hipPeekAtLastError();
        if (le != hipSuccess) { fprintf(stderr, "kernel_launch: launch %d failed: %s\n", li, hipGetErrorName(le)); break; }
    }
}
```

```cpp
#include <hip/hip_runtime.h>
#include <cstdio>
#include <cstdint>

#define LAS __attribute__((address_space(3)))
#define GAS __attribute__((address_space(1)))
typedef unsigned short f16_t;
typedef _Float16 f16x8 __attribute__((ext_vector_type(8)));
typedef _Float16 f16x4 __attribute__((ext_vector_type(4)));
typedef _Float16 f16x2 __attribute__((ext_vector_type(2)));
typedef float f32x2 __attribute__((ext_vector_type(2)));
typedef float f32x4 __attribute__((ext_vector_type(4)));
typedef float f32x16 __attribute__((ext_vector_type(16)));
typedef unsigned u32x2 __attribute__((ext_vector_type(2)));
typedef unsigned u32x4 __attribute__((ext_vector_type(4)));
typedef short v4i16_t __attribute__((ext_vector_type(4)));

constexpr int DM = 1024, BATCH = 16, SEQ = 4096, MTOK = BATCH * SEQ;
constexpr int NH = 8, HD = 64, AW = 512, IH = 8, ID = 32, TOPK = 256, CW = 512, DFF = 2816;
constexpr int IN_COLS = 2472, NIN = 2560;
constexpr int NGU = 2 * DFF;
#ifndef SEL16
#define SEL16 1
#endif
#ifndef FFN_BF16
#define FFN_BF16 1
#endif
constexpr bool FFN_BF = FFN_BF16 != 0;
constexpr float EPS = 1e-5f;
constexpr float DN_ALPHA = 1.189207115002721f;
constexpr float QSCALE = 0.125f * 1.4426950408889634f;

typedef __bf16 bf16x8_t __attribute__((ext_vector_type(8)));
typedef __bf16 bf16x2_t __attribute__((ext_vector_type(2)));
__device__ __forceinline__ unsigned pkb(float lo, float hi) { f32x2 v = {lo, hi}; return __builtin_bit_cast(unsigned, __builtin_convertvector(v, bf16x2_t)); }
__device__ __forceinline__ unsigned pkh(float lo, float hi) { f32x2 v = {lo, hi}; return __builtin_bit_cast(unsigned, __builtin_convertvector(v, f16x2)); }
__device__ __forceinline__ float wave_sum(float v) {
#define WS_STEP(ctrl, rm, bc) v += __builtin_bit_cast(float, __builtin_amdgcn_update_dpp(0, __builtin_bit_cast(int, v), ctrl, rm, 0xf, bc))
    WS_STEP(0x111, 0xf, true); WS_STEP(0x112, 0xf, true); WS_STEP(0x114, 0xf, true); WS_STEP(0x118, 0xf, true); WS_STEP(0x142, 0xa, false); WS_STEP(0x143, 0xc, false);
#undef WS_STEP
    return __builtin_bit_cast(float, __builtin_amdgcn_readlane(__builtin_bit_cast(int, v), 63));
}

namespace pg8 {
#define PG8_LAS __attribute__((address_space(3)))
constexpr int BM = 256, BK = 64, HALF = 128, HTB = HALF * BK * 2, STAGE_BYTES = 8 * HTB, NXCD = 8, WGM = 8;
__host__ __device__ __forceinline__ int lds_byte(int r, int c) { const int st = (r >> 4) * 2 + (c >> 5), rr = r & 15, cc = c & 31, ob = rr * 64 + cc * 2; return st * 1024 + (ob ^ (((ob >> 9) & 1) << 5)); }
__host__ __device__ __forceinline__ void stage_rc(int b, int& R, int& C) { const int st = b / 1024, sb = b % 1024, swz = sb ^ (((sb >> 9) & 1) << 5); R = (st >> 1) * 16 + swz / 64; C = (st & 1) * 32 + (swz % 64) / 2; }
__host__ __device__ __forceinline__ int perm32(int rho) { const int n = rho >> 4, i = rho & 15; return 8 * (i >> 2) + 4 * n + (i & 3); }
struct Unit { int pm, pn; };
struct Gemm { const f16_t* A; const f16_t* Bt; int M, N, K; };
struct StaticOrder {
    int nM, nN, nwg, G, c;
    __host__ __device__ void init(int M, int N, int G_, int c_) { nM = M / BM; nN = N / BM; nwg = nM * nN; G = G_; c = c_; }
    __host__ __device__ bool next(int i, Unit& u) const {
        const long L = (long)i * G + c; if (L >= nwg) return false;
        int wgid = (int)L; { const int q = nwg / NXCD, r = nwg % NXCD, xcd = wgid % NXCD, off = wgid / NXCD; wgid = (xcd < r ? xcd * (q + 1) : r * (q + 1) + (xcd - r) * q) + off; }
        const int nig = WGM * nN, gid = wgid / nig, fm = gid * WGM, gsz = (nM - fm) < WGM ? (nM - fm) : WGM;
        u.pm = fm + ((wgid % nig) % gsz); u.pn = (wgid % nig) / gsz; return true;
    }
    __device__ __forceinline__ void a_ready(const Unit&) const {}
    __device__ __forceinline__ void done(const Unit&) const {}
};


struct EpiInProj {
    static constexpr bool PERM = true, AFTER_DRAIN = false;
    f16_t *Q, *K, *V, *QI, *KI, *GB, *U; float* WI; const float* rope;
    __device__ __forceinline__ static void rot8(f32x4& v0, f32x4& v1, const float* rp) {
        const f32x4 c0 = *(const f32x4*)rp, c1 = *(const f32x4*)(rp + 4);
        f32x4 a, b;
        a[0] = v0[0] * c0[0] - v0[1] * c0[1]; a[1] = v0[1] * c0[0] + v0[0] * c0[1];
        a[2] = v0[2] * c0[2] - v0[3] * c0[3]; a[3] = v0[3] * c0[2] + v0[2] * c0[3];
        b[0] = v1[0] * c1[0] - v1[1] * c1[1]; b[1] = v1[1] * c1[0] + v1[0] * c1[1];
        b[2] = v1[2] * c1[2] - v1[3] * c1[3]; b[3] = v1[3] * c1[2] + v1[2] * c1[3];
        v0 = a; v1 = b;
    }
    __device__ __forceinline__ static u32x4 pack8(const f32x4& v0, const f32x4& v1) { u32x4 w; w.x = pkh(v0[0], v0[1]); w.y = pkh(v0[2], v0[3]); w.z = pkh(v1[0], v1[1]); w.w = pkh(v1[2], v1[3]); return w; }
    __device__ __forceinline__ static void rot8_sel(f32x4& v0, f32x4& v1, const f32x4 c0, const f32x4 c1, bool on) {
        f32x4 a, b;
        a[0] = v0[0] * c0[0] - v0[1] * c0[1]; a[1] = v0[1] * c0[0] + v0[0] * c0[1];
        a[2] = v0[2] * c0[2] - v0[3] * c0[3]; a[3] = v0[3] * c0[2] + v0[2] * c0[3];
        b[0] = v1[0] * c1[0] - v1[1] * c1[1]; b[1] = v1[1] * c1[0] + v1[0] * c1[1];
        b[2] = v1[2] * c1[2] - v1[3] * c1[3]; b[3] = v1[3] * c1[2] + v1[2] * c1[3];
        v0 = on ? a : v0; v1 = on ? b : v1;
    }
    __device__ __forceinline__ void operator()(const f32x4 (&acc)[2][2][4][2], const Unit& u, int wr, int wc, int fr, int fq) const {
        const int row0 = u.pm * BM + wr * 64 + fr, pn = u.pn;
        if (pn < 2 || pn == 3) {
            const int hw = (pn == 3) ? 31 : 63;
            f16_t* const dst = (pn == 3) ? QI : Q; const int pitch = (pn == 3) ? IH * ID : AW; const float sc = (pn == 3) ? 1.0f : QSCALE;
            const int cb = (pn == 3) ? 0 : pn * 256;
            int d0[2]; bool on[2];
#pragma unroll
            for (int bj = 0; bj < 2; ++bj) { const int cl = bj * HALF + wc * 32 + 8 * fq; d0[bj] = (cb + cl) & hw; on[bj] = d0[bj] < 16; }
#pragma unroll
            for (int ai = 0; ai < 2; ++ai) {
                f32x4 cs[4][2][2];
#pragma unroll
                for (int m = 0; m < 4; ++m) { const int t = (row0 + ai * HALF + m * 16) & (SEQ - 1); const float* rp = rope + (size_t)t * 16;
#pragma unroll
                    for (int bj = 0; bj < 2; ++bj) { cs[m][bj][0] = *(const f32x4*)(rp + (d0[bj] & 8)); cs[m][bj][1] = *(const f32x4*)(rp + (d0[bj] & 8) + 4); } }
#pragma unroll
                for (int m = 0; m < 4; ++m) { const int row = row0 + ai * HALF + m * 16;
#pragma unroll
                    for (int bj = 0; bj < 2; ++bj) { f32x4 v0 = acc[ai][bj][m][0], v1 = acc[ai][bj][m][1];
                        rot8_sel(v0, v1, cs[m][bj][0], cs[m][bj][1], on[bj]);
                        v0 = v0 * sc; v1 = v1 * sc;
                        *(u32x4*)(dst + (size_t)row * pitch + cb + bj * HALF + wc * 32 + 8 * fq) = pack8(v0, v1); } }
            }
            return;
        }
#pragma unroll
        for (int ai = 0; ai < 2; ++ai)
#pragma unroll
            for (int m = 0; m < 4; ++m) {
                const int row = row0 + ai * HALF + m * 16; const int t = row & (SEQ - 1);
                const float* rp = rope + (size_t)t * 16;
                if (pn >= 6) {
                    const f32x4 g0 = acc[ai][0][m][0], g1 = acc[ai][0][m][1], h0 = acc[ai][1][m][0], h1 = acc[ai][1][m][1];
                    u32x4 w; w.x = pkh(g0[0] * h0[0], g0[1] * h0[1]); w.y = pkh(g0[2] * h0[2], g0[3] * h0[3]); w.z = pkh(g1[0] * h1[0], g1[1] * h1[1]); w.w = pkh(g1[2] * h1[2], g1[3] * h1[3]);
                    *(u32x4*)(U + (size_t)row * CW + (pn - 6) * HALF + wc * 32 + 8 * fq) = w;
                    continue;
                }
#pragma unroll
                for (int bj = 0; bj < 2; ++bj) {
                    f32x4 v0 = acc[ai][bj][m][0], v1 = acc[ai][bj][m][1];
                    const int cl = bj * HALF + wc * 32 + 8 * fq;
                    if (pn == 2) {
                        if (cl < 64) { if (cl < 16) rot8(v0, v1, rp + cl); *(u32x4*)(K + (size_t)row * HD + cl) = pack8(v0, v1); }
                        else if (cl < 128) { *(u32x4*)(V + (size_t)row * HD + (cl - 64)) = pack8(v0, v1); }
                        else if (cl < 160) { const int d0 = cl - 128; if (d0 < 16) rot8(v0, v1, rp + d0); *(u32x4*)(KI + (size_t)row * ID + d0) = pack8(v0, v1); }
                        else if (cl < 168) { float* wp = WI + (size_t)row * IH; *(f32x4*)wp = v0 * 0.0625f; *(f32x4*)(wp + 4) = v1 * 0.0625f; }
                    } else {
                        *(u32x4*)(GB + (size_t)row * CW + (pn - 4) * 256 + cl) = pack8(v0, v1);
                    }
                }
            }
    }
};
template <bool BASE16> struct EpiResGate {
    static constexpr bool PERM = true, AFTER_DRAIN = false;
    const void* base; f16_t* out; const float* gate;
    __device__ __forceinline__ void operator()(const f32x4 (&acc)[2][2][4][2], const Unit& u, int wr, int wc, int fr, int fq) const {
        const int row0 = u.pm * BM + wr * 64 + fr, col0 = u.pn * BM + wc * 32 + 8 * fq;
        const float* gp = gate + (size_t)((u.pm * BM) / SEQ) * (6 * DM) + col0;
        f32x4 gv[2][2];
#pragma unroll
        for (int bj = 0; bj < 2; ++bj)
#pragma unroll
            for (int n = 0; n < 2; ++n) gv[bj][n] = *(const f32x4*)(gp + bj * HALF + 4 * n);
#pragma unroll
        for (int ai = 0; ai < 2; ++ai) {
            f32x4 b0[4][2], b1[4][2]; u32x4 raw[4][2];
#pragma unroll
            for (int m = 0; m < 4; ++m) { const size_t off = (size_t)(row0 + ai * HALF + m * 16) * DM + col0;
#pragma unroll
                for (int bj = 0; bj < 2; ++bj) {
                    if (BASE16) raw[m][bj] = *(const u32x4*)((const f16_t*)base + off + bj * HALF);
                    else { const float* bp = (const float*)base + off + bj * HALF; b0[m][bj] = *(const f32x4*)bp; b1[m][bj] = *(const f32x4*)(bp + 4); } } }
            asm volatile("" ::: "memory");
#pragma unroll
            for (int m = 0; m < 4; ++m) { const size_t off = (size_t)(row0 + ai * HALF + m * 16) * DM + col0;
#pragma unroll
                for (int bj = 0; bj < 2; ++bj) {
                    if (BASE16) { const f16x8 hv = __builtin_bit_cast(f16x8, raw[m][bj]);
                        b0[m][bj] = (f32x4){(float)hv[0], (float)hv[1], (float)hv[2], (float)hv[3]}; b1[m][bj] = (f32x4){(float)hv[4], (float)hv[5], (float)hv[6], (float)hv[7]}; }
                    const f32x4 y0 = b0[m][bj] * DN_ALPHA + gv[bj][0] * acc[ai][bj][m][0], y1 = b1[m][bj] * DN_ALPHA + gv[bj][1] * acc[ai][bj][m][1];
                    u32x4 w; w.x = pkh(y0[0], y0[1]); w.y = pkh(y0[2], y0[3]); w.z = pkh(y1[0], y1[1]); w.w = pkh(y1[2], y1[3]);
                    *(u32x4*)(out + off + bj * HALF) = w; } }
        }
    }
};
struct EpiSwiGLU {
    static constexpr bool PERM = true, AFTER_DRAIN = false;
    f16_t* H;
    __device__ __forceinline__ static float silu(float g) { return g * __builtin_amdgcn_rcpf(1.0f + __builtin_amdgcn_exp2f(-1.4426950408889634f * g)); }
    __device__ __forceinline__ void operator()(const f32x4 (&acc)[2][2][4][2], const Unit& u, int wr, int wc, int fr, int fq) const {
        const int row0 = u.pm * BM + wr * 64 + fr, j = u.pn * HALF + wc * 32 + 8 * fq;
#pragma unroll
        for (int ai = 0; ai < 2; ++ai)
#pragma unroll
            for (int m = 0; m < 4; ++m) { f16_t* rowp = H + (size_t)(row0 + ai * HALF + m * 16) * DFF + j;
                const f32x4 g0 = acc[ai][0][m][0], g1 = acc[ai][0][m][1], u0 = acc[ai][1][m][0], u1 = acc[ai][1][m][1];
                u32x4 w;
                if (FFN_BF) { w.x = pkb(silu(g0[0]) * u0[0], silu(g0[1]) * u0[1]); w.y = pkb(silu(g0[2]) * u0[2], silu(g0[3]) * u0[3]); w.z = pkb(silu(g1[0]) * u1[0], silu(g1[1]) * u1[1]); w.w = pkb(silu(g1[2]) * u1[2], silu(g1[3]) * u1[3]); }
                else { w.x = pkh(silu(g0[0]) * u0[0], silu(g0[1]) * u0[1]); w.y = pkh(silu(g0[2]) * u0[2], silu(g0[3]) * u0[3]); w.z = pkh(silu(g1[0]) * u1[0], silu(g1[1]) * u1[1]); w.w = pkh(silu(g1[2]) * u1[2], silu(g1[3]) * u1[3]); }
                *(u32x4*)rowp = w; }
    }
};

template <class Epi, class Sched, bool ALIGN_EPI = false, bool SP2 = false, bool BF = false>
__device__ __forceinline__ void gemm_phase(PG8_LAS unsigned char* lds, const Gemm g, const Sched& S, const Epi& E) {
    const int tid = threadIdx.x, wid = __builtin_amdgcn_readfirstlane(tid >> 6), lane = tid & 63, wr = wid >> 2, wc = wid & 3, fr = lane & 15, fq = lane >> 4;
    const int K = g.K, nt = K / BK;
    unsigned voffA[2], voffB[2];
#pragma unroll
    for (int i = 0; i < 2; ++i) { int R, C; stage_rc(tid * 16 + i * 8192, R, C); const int Rb = Epi::PERM ? ((R & ~31) + perm32(R & 31)) : R;
        voffA[i] = (unsigned)(R * K + C) * 2u; voffB[i] = (unsigned)(Rb * K + C) * 2u; }
    const size_t kstep = (size_t)(BK * 2);
    const size_t hstep = (size_t)HALF * K * 2;
    const size_t tstep = 2 * hstep;
    const unsigned ldsw = (unsigned)wid * 1024u;
    const int aoff = lds_byte(wr * 64 + fr, fq * 8), boff = lds_byte(wc * 32 + fr, fq * 8);
#define PG8_SA(b, h) (((b) * 2 + (h)) * HTB)
#define PG8_SB(b, h) ((4 + (b) * 2 + (h)) * HTB)
#define PG8_STAGE(bufoff, gbase, voff) do { _Pragma("unroll") for (int _i = 0; _i < 2; ++_i) \
        __builtin_amdgcn_global_load_lds((const unsigned*)((const char*)(gbase) + (voff)[_i]), (PG8_LAS unsigned*)(lds + (bufoff) + ldsw + _i * 8192), 16, 0, 0); } while (0)
#define PG8_LDA(dst, b, h) do { _Pragma("unroll") for (int m = 0; m < 4; ++m) _Pragma("unroll") for (int k = 0; k < 2; ++k) dst[m][k] = *(const PG8_LAS f16x8*)(lds + PG8_SA(b, h) + aoff + m * 2048 + k * 1024); } while (0)
#define PG8_LDB(dst, b, h) do { _Pragma("unroll") for (int n = 0; n < 2; ++n) _Pragma("unroll") for (int k = 0; k < 2; ++k) dst[n][k] = *(const PG8_LAS f16x8*)(lds + PG8_SB(b, h) + boff + n * 2048 + k * 1024); } while (0)
#define PG8_MMA(ai, bj, At, Bt) do { __builtin_amdgcn_s_setprio(1); _Pragma("unroll") for (int m = 0; m < 4; ++m) _Pragma("unroll") for (int n = 0; n < 2; ++n) _Pragma("unroll") for (int k = 0; k < 2; ++k) \
        acc[ai][bj][m][n] = BF ? __builtin_amdgcn_mfma_f32_16x16x32_bf16(__builtin_bit_cast(bf16x8_t, Bt[n][k]), __builtin_bit_cast(bf16x8_t, At[m][k]), acc[ai][bj][m][n], 0, 0, 0) : __builtin_amdgcn_mfma_f32_16x16x32_f16(Bt[n][k], At[m][k], acc[ai][bj][m][n], 0, 0, 0); __builtin_amdgcn_s_setprio(0); } while (0)
#define PG8_WAIT_V(n) asm volatile("s_waitcnt vmcnt(" #n ")" ::: "memory")
#define PG8_WAIT_L(n) asm volatile("s_waitcnt lgkmcnt(" #n ")" ::: "memory")
#define PG8_BAR __builtin_amdgcn_s_barrier()
#define PG8_SCHED __builtin_amdgcn_sched_barrier(0)
    Unit cur, nxt; int ui = 0;
    if (!S.next(0, cur)) return;
    f32x4 acc[2][2][4][2];
#pragma unroll
    for (int a = 0; a < 2; ++a)
#pragma unroll
        for (int b = 0; b < 2; ++b)
#pragma unroll
            for (int m = 0; m < 4; ++m)
#pragma unroll
                for (int n = 0; n < 2; ++n) acc[a][b][m][n] = (f32x4){0.f, 0.f, 0.f, 0.f};
    f16x8 At[4][2], B0[2][2], B1[2][2];
    const char* cA = (const char*)g.A + (size_t)cur.pm * tstep; const char* cB = (const char*)g.Bt + (size_t)cur.pn * tstep;
    S.a_ready(cur);
    if constexpr (SP2) {
        PG8_STAGE(PG8_SB(0, 0), cB, voffB); PG8_STAGE(PG8_SB(0, 1), cB + hstep, voffB); PG8_STAGE(PG8_SA(0, 0), cA, voffA); PG8_STAGE(PG8_SA(0, 1), cA + hstep, voffA);
        if (wr == 1) PG8_BAR;
        PG8_WAIT_V(2); PG8_BAR;
        PG8_STAGE(PG8_SB(1, 0), cB + kstep, voffB); PG8_STAGE(PG8_SA(1, 0), cA + kstep, voffA); PG8_STAGE(PG8_SB(1, 1), cB + hstep + kstep, voffB);
        PG8_WAIT_V(6); PG8_BAR;
    } else {
        PG8_STAGE(PG8_SB(0, 0), cB, voffB); PG8_STAGE(PG8_SA(0, 0), cA, voffA); PG8_STAGE(PG8_SB(0, 1), cB + hstep, voffB); PG8_STAGE(PG8_SA(0, 1), cA + hstep, voffA);
        if (wr == 1) PG8_BAR;
        PG8_WAIT_V(4); PG8_BAR;
        PG8_STAGE(PG8_SB(1, 0), cB + kstep, voffB); PG8_STAGE(PG8_SA(1, 0), cA + kstep, voffA); PG8_STAGE(PG8_SB(1, 1), cB + hstep + kstep, voffB);
        PG8_WAIT_V(6); PG8_BAR;
    }
    for (;;) {
        const bool has_next = S.next(ui + 1, nxt);
        const char* nA = has_next ? (const char*)g.A + (size_t)nxt.pm * tstep : cA; const char* nB = has_next ? (const char*)g.Bt + (size_t)nxt.pn * tstep : cB;
        for (int t = 0; t < nt; t += 2) {
            const bool last = (t == nt - 2);
            const char* a1 = cA + (size_t)(t + 1) * kstep;
            const char* a2 = last ? nA : cA + (size_t)(t + 2) * kstep; const char* b2 = last ? nB : cB + (size_t)(t + 2) * kstep;
            const char* a3 = a2 + kstep; const char* b3 = b2 + kstep;
            if (last && has_next) S.a_ready(nxt);
            if constexpr (SP2) {
            PG8_LDB(B0, 0, 0); PG8_LDB(B1, 0, 1); PG8_SCHED; PG8_LDA(At, 0, 0); PG8_STAGE(PG8_SA(1, 1), a1 + hstep, voffA);
            PG8_WAIT_V(8); PG8_WAIT_L(0); PG8_BAR; PG8_MMA(0, 0, At, B0); PG8_MMA(0, 1, At, B1); PG8_BAR; PG8_SCHED;
            PG8_LDA(At, 0, 1); PG8_STAGE(PG8_SB(0, 0), b2, voffB); PG8_STAGE(PG8_SB(0, 1), b2 + hstep, voffB); PG8_STAGE(PG8_SA(0, 0), a2, voffA);
            PG8_WAIT_V(8); PG8_WAIT_L(0); PG8_BAR; PG8_MMA(1, 0, At, B0); PG8_MMA(1, 1, At, B1); PG8_BAR; PG8_SCHED;
            PG8_LDB(B0, 1, 0); PG8_LDB(B1, 1, 1); PG8_SCHED; PG8_LDA(At, 1, 0); PG8_STAGE(PG8_SA(0, 1), a2 + hstep, voffA);
            PG8_WAIT_V(8); PG8_WAIT_L(0); PG8_BAR; PG8_MMA(0, 0, At, B0); PG8_MMA(0, 1, At, B1); PG8_BAR; PG8_SCHED;
            PG8_LDA(At, 1, 1); PG8_STAGE(PG8_SB(1, 0), b3, voffB); PG8_STAGE(PG8_SB(1, 1), b3 + hstep, voffB); PG8_STAGE(PG8_SA(1, 0), a3, voffA);
            PG8_WAIT_V(8); PG8_WAIT_L(0); PG8_BAR; PG8_MMA(1, 0, At, B0); PG8_MMA(1, 1, At, B1); PG8_BAR; PG8_SCHED;
            } else {
            PG8_LDB(B0, 0, 0); PG8_SCHED; PG8_LDA(At, 0, 0); PG8_STAGE(PG8_SA(1, 1), a1 + hstep, voffA);
            PG8_WAIT_L(8); PG8_BAR; PG8_WAIT_L(0); PG8_MMA(0, 0, At, B0); PG8_BAR; PG8_SCHED;
            PG8_LDB(B1, 0, 1); PG8_STAGE(PG8_SB(0, 0), b2, voffB);
            PG8_BAR; PG8_WAIT_L(0); PG8_MMA(0, 1, At, B1); PG8_BAR;
            PG8_LDA(At, 0, 1); PG8_STAGE(PG8_SA(0, 0), a2, voffA);
            PG8_BAR; PG8_WAIT_L(0); PG8_MMA(1, 0, At, B0); PG8_BAR; PG8_SCHED;
            PG8_STAGE(PG8_SB(0, 1), b2 + hstep, voffB);
            PG8_WAIT_V(6); PG8_BAR; PG8_MMA(1, 1, At, B1); PG8_BAR;
            PG8_LDB(B0, 1, 0); PG8_SCHED; PG8_LDA(At, 1, 0); PG8_STAGE(PG8_SA(0, 1), a2 + hstep, voffA);
            PG8_WAIT_L(8); PG8_BAR; PG8_WAIT_L(0); PG8_MMA(0, 0, At, B0); PG8_BAR; PG8_SCHED;
            PG8_LDB(B1, 1, 1); PG8_STAGE(PG8_SB(1, 0), b3, voffB);
            PG8_BAR; PG8_WAIT_L(0); PG8_MMA(0, 1, At, B1); PG8_BAR;
            PG8_LDA(At, 1, 1); PG8_STAGE(PG8_SA(1, 0), a3, voffA);
            PG8_BAR; PG8_WAIT_L(0); PG8_MMA(1, 0, At, B0); PG8_BAR; PG8_SCHED;
            PG8_STAGE(PG8_SB(1, 1), b3 + hstep, voffB);
            PG8_WAIT_V(6); PG8_BAR; PG8_MMA(1, 1, At, B1); PG8_BAR;
            }
        }
        if constexpr (ALIGN_EPI) { if (wr == 0) PG8_BAR; }
        if constexpr (!Epi::AFTER_DRAIN) { E(acc, cur, wr, wc, fr, fq); S.done(cur); }
        if (!has_next) break;
#pragma unroll
        for (int a = 0; a < 2; ++a)
#pragma unroll
            for (int b = 0; b < 2; ++b)
#pragma unroll
                for (int m = 0; m < 4; ++m)
#pragma unroll
                    for (int n = 0; n < 2; ++n) acc[a][b][m][n] = (f32x4){0.f, 0.f, 0.f, 0.f};
        cur = nxt; cA = nA; cB = nB; ++ui;
        if constexpr (ALIGN_EPI) { if (wr == 1) PG8_BAR; }
    }
    PG8_WAIT_V(0);
    if constexpr (!ALIGN_EPI) { if (wr == 0) PG8_BAR; }
    PG8_BAR;
    if constexpr (Epi::AFTER_DRAIN) { E.fused(acc, cur, wr, wc, fr, fq, lds, wid, lane); S.done(cur); }
#undef PG8_SA
#undef PG8_SB
#undef PG8_STAGE
#undef PG8_LDA
#undef PG8_LDB
#undef PG8_MMA
#undef PG8_WAIT_V
#undef PG8_WAIT_L
#undef PG8_BAR
#undef PG8_SCHED
}
}

constexpr size_t MiB = 1u << 20;
constexpr size_t WS_CTL = 0, CTL_ZERO_BYTES = 64 * 1024;
constexpr size_t WS_MODP = 1 * MiB;
constexpr size_t WS_MOD = 4 * MiB;
constexpr size_t WS_ROPE = 5 * MiB;
constexpr size_t WS_WIN = 6 * MiB;
constexpr size_t WS_WOUT = 11 * MiB;
constexpr size_t WS_WGU = 13 * MiB;
constexpr size_t WS_WDN = 24 * MiB;
constexpr size_t WS_XN = 32 * MiB;
constexpr size_t WS_Q = 160 * MiB;
constexpr size_t WS_K = 224 * MiB;
constexpr size_t WS_V = 232 * MiB;
constexpr size_t WS_QI = 240 * MiB;
constexpr size_t WS_KI = 272 * MiB;
constexpr size_t WS_WI = 276 * MiB;
constexpr size_t WS_GB = 278 * MiB;
constexpr size_t WS_U = 342 * MiB;
constexpr size_t WS_MIX = 406 * MiB;
constexpr size_t WS_H = 160 * MiB;
constexpr size_t WS_X1 = 544 * MiB;
constexpr size_t WS_END = 800 * MiB;
static_assert(WS_H + (size_t)MTOK * DFF * 2 <= WS_X1 && WS_MIX + (size_t)MTOK * DM * 2 <= WS_X1, "ws map");
constexpr int CW_BAR = 1024;

constexpr int RING_OFF = 0, RING_BYTES = 131072;
constexpr int LDSCTL_OFF = RING_BYTES + 16384 + 4096 + 256 + 8192, MISC_OFF = LDSCTL_OFF + 320;
constexpr int LDS_BYTES = 162048;
constexpr int NWAVES = 8;

#define LDS_WAIT() asm volatile("s_waitcnt lgkmcnt(0)" ::: "memory")
#define VM_WAIT() asm volatile("s_waitcnt vmcnt(0)" ::: "memory")

#define XB_TMO      128
#define XB_XCNT(j)  (256  + 64 * (j))
#define XB_XSUB(j)  (1280 + 64 * (j))
#define XB_XGEN(j)  (2304 + 64 * (j))
#define XB_TOP      3328
#define XB_TOPGEN   3392
#define XCD_BAR_WORDS 3456
#define XB_SPIN_CAP (1u << 20)

__device__ __forceinline__ unsigned xb_ld(unsigned* p)              { return __hip_atomic_load(p, __ATOMIC_RELAXED, __HIP_MEMORY_SCOPE_AGENT); }
__device__ __forceinline__ unsigned xb_add(unsigned* p, unsigned v) { return __hip_atomic_fetch_add(p, v, __ATOMIC_RELAXED, __HIP_MEMORY_SCOPE_AGENT); }
__device__ __forceinline__ unsigned xb_xcc_id() { return (unsigned)__builtin_amdgcn_s_getreg((3 << 11) | 20) & 0xFu; }
#define XB_SPIN(cond, bar) do { unsigned _sp = 0; while (cond) { __builtin_amdgcn_s_sleep(1); \
    if ((++_sp & 255u) == 0u) { if (xb_ld(&(bar)[XB_TMO])) break; if (_sp > XB_SPIN_CAP) { atomicAdd(&(bar)[XB_TMO], 1u); break; } } } } while (0)

struct XcdBarrier {
    unsigned* bar; unsigned x;
    volatile LAS unsigned* st;
};

__device__ __forceinline__ XcdBarrier xcd_barrier_post(unsigned* bar, volatile LAS unsigned* st) {
    XcdBarrier b; b.bar = bar; b.x = xb_xcc_id(); b.st = st;
    if (threadIdx.x == 0) (void)xb_add(&bar[XB_XCNT(b.x)], 1u);
    return b;
}
__device__ __forceinline__ void xcd_barrier_complete(unsigned* bar, unsigned x, unsigned& nloc, unsigned& nx) {
    const unsigned G = gridDim.x * gridDim.y * gridDim.z;
    unsigned sum, cnt, mine, sp = 0u;
    for (;;) {
        sum = 0u; cnt = 0u; mine = 0u;
#pragma unroll
        for (unsigned j = 0; j < 16; ++j) { const unsigned c = xb_ld(&bar[XB_XCNT(j)]); sum += c; cnt += (c > 0u) ? 1u : 0u; mine = (j == x) ? c : mine; }
        if (sum == G) break;
        __builtin_amdgcn_s_sleep(1);
        if ((++sp & 255u) == 0u) { if (xb_ld(&bar[XB_TMO])) break; if (sp > XB_SPIN_CAP) { atomicAdd(&bar[XB_TMO], 1u); break; } }
    }
    nloc = mine > 0u ? mine : 1u; nx = cnt > 0u ? cnt : 1u;
}

__device__ __forceinline__ void xcd_barrier(const XcdBarrier& b) {
    asm volatile("s_waitcnt vmcnt(0)" ::: "memory");
    __syncthreads();
    if (threadIdx.x == 0) {
        unsigned* bar = b.bar;
        __builtin_amdgcn_s_waitcnt(0);
        unsigned nloc = b.st[0], nx = b.st[1];
        if (nloc == 0u) { xcd_barrier_complete(bar, b.x, nloc, nx); b.st[0] = nloc; b.st[1] = nx; }
        const unsigned old = xb_add(&bar[XB_XSUB(b.x)], 1u);
        const unsigned gen = old / nloc;
        if (old + 1u == (gen + 1u) * nloc) {
            __builtin_amdgcn_fence(__ATOMIC_RELEASE, "agent");
            asm volatile("s_waitcnt vmcnt(0)" ::: "memory");
            const unsigned og = xb_add(&bar[XB_TOP], 1u);
            const unsigned tg = og / nx;
            if (og + 1u == (tg + 1u) * nx) xb_add(&bar[XB_TOPGEN], 1u);
            else XB_SPIN(xb_ld(&bar[XB_TOPGEN]) == tg, bar);
            __builtin_amdgcn_fence(__ATOMIC_ACQUIRE, "agent");
            xb_add(&bar[XB_XGEN(b.x)], 1u);
            asm volatile("s_waitcnt vmcnt(0)" ::: "memory");
        } else {
            XB_SPIN(xb_ld(&bar[XB_XGEN(b.x)]) == gen, bar);
            __builtin_amdgcn_fence(__ATOMIC_ACQUIRE, "agent");
            asm volatile("s_waitcnt vmcnt(0)" ::: "memory");
        }
    }
    __syncthreads();
}

struct Frame {
    LAS unsigned char* lds;
    volatile LAS unsigned* MISC;
    unsigned* ctl;
    int tid, lane, wave, vcu, G;
    const float *x, *c, *w_ada, *b_ada, *w_in, *conv_w, *attn_g, *conv_g, *w_out, *ln1_g, *ln1_b, *w_gate, *w_up, *w_down, *ln2_g, *ln2_b;
    float* out;
    float *MODP, *MOD, *ROPE, *WI;
    f16_t *X1H, *YH;
    f16_t *WIN, *WOUT, *WGU, *WDN, *XN, *Q, *K, *V, *QI, *KI, *GB, *U, *MIX, *H;
};

__device__ __forceinline__ int rperm(int d) { return d < 8 ? 2 * d : (d < 16 ? 2 * (d - 8) + 1 : d); }
__device__ __forceinline__ int inproj_dst(int c) {
    if (c < 512) return (c & ~63) + rperm(c & 63);
    if (c < 576) return 512 + rperm(c - 512);
    if (c < 640) return c;
    if (c < 896) { const int e = c - 640; return 768 + (e & ~31) + rperm(e & 31); }
    if (c < 928) return 640 + rperm(c - 896);
    if (c < 936) return 672 + (c - 928);
    if (c < 1448) return 1024 + (c - 936);
    if (c < 1960) { const int j = c - 1448; return 1536 + (j >> 7) * 256 + (j & 127); }
    { const int j = c - 1960; return 1536 + (j >> 7) * 256 + 128 + (j & 127); }
}
template <int MODE, bool BF = false> __device__ __forceinline__ void p0_transpose_item(const float* W, int K, int N, f16_t* WT, LAS float* scr, int item, int lane) {
    const int nblk = (N + 31) / 32, kb = item / nblk, nb = item % nblk, k0 = 64 * kb, n0 = 32 * nb;
    const int colr = n0 + (lane & 31);
    { float tv[32]; const float* wp = W + (size_t)(k0 + (lane >> 5)) * N + (colr < N ? colr : 0);
#pragma unroll
      for (int i = 0; i < 32; ++i) tv[i] = wp[(size_t)(2 * i) * N];
#pragma unroll
      for (int i = 0; i < 32; ++i) scr[(2 * i + (lane >> 5)) * 33 + (lane & 31)] = colr < N ? tv[i] : 0.f; }
    LDS_WAIT(); asm volatile("" ::: "memory");
    const int c = lane & 7;
#pragma unroll
    for (int j = 0; j < 4; ++j) { const int n = (lane >> 3) + 8 * j; const int col = n0 + n; const LAS float* s = scr + (8 * c) * 33 + n;
        u32x4 o; if (BF) { o.x = pkb(s[0 * 33], s[1 * 33]); o.y = pkb(s[2 * 33], s[3 * 33]); o.z = pkb(s[4 * 33], s[5 * 33]); o.w = pkb(s[6 * 33], s[7 * 33]); }
        else { o.x = pkh(s[0 * 33], s[1 * 33]); o.y = pkh(s[2 * 33], s[3 * 33]); o.z = pkh(s[4 * 33], s[5 * 33]); o.w = pkh(s[6 * 33], s[7 * 33]); }
        if (col < N) { int dr = col; if (MODE == 1) dr = inproj_dst(col); if (MODE == 2) dr = (col >> 7) * 256 + (col & 127); if (MODE == 3) dr = (col >> 7) * 256 + 128 + (col & 127);
            *(u32x4*)(WT + (size_t)dr * K + k0 + 8 * c) = o; } }
    LDS_WAIT(); asm volatile("" ::: "memory");
}
__device__ __forceinline__ void p0_ada_item(Frame& F, LAS float* scr, int item) {
    const int cb = item % 96, ks = item / 96, k0 = ks * 128, lane = F.lane;
#pragma unroll 4
    for (int i = 0; i < 32; ++i) { const int idx = lane + 64 * i, b = idx >> 7, kk = idx & 127; const float cv = F.c[b * DM + k0 + kk];
        scr[kk * 16 + b] = cv / (1.0f + __expf(-cv)); }
    LDS_WAIT(); asm volatile("" ::: "memory");
    float acc[16];
#pragma unroll
    for (int b = 0; b < 16; ++b) acc[b] = 0.f;
    const float* wp = F.w_ada + (size_t)k0 * (6 * DM) + cb * 64 + lane;
#pragma unroll 1
    for (int k4 = 0; k4 < 128; k4 += 32) { float wvv[32];
#pragma unroll
      for (int i = 0; i < 32; ++i) wvv[i] = wp[(size_t)(k4 + i) * (6 * DM)];
#pragma unroll
      for (int i = 0; i < 32; ++i) { const int kk = k4 + i; const float wv = wvv[i];
        const LAS f32x4* sp = (const LAS f32x4*)(scr + kk * 16);
        const f32x4 s0 = sp[0], s1 = sp[1], s2 = sp[2], s3 = sp[3];
        acc[0] += s0[0] * wv; acc[1] += s0[1] * wv; acc[2] += s0[2] * wv; acc[3] += s0[3] * wv;
        acc[4] += s1[0] * wv; acc[5] += s1[1] * wv; acc[6] += s1[2] * wv; acc[7] += s1[3] * wv;
        acc[8] += s2[0] * wv; acc[9] += s2[1] * wv; acc[10] += s2[2] * wv; acc[11] += s2[3] * wv;
        acc[12] += s3[0] * wv; acc[13] += s3[1] * wv; acc[14] += s3[2] * wv; acc[15] += s3[3] * wv; } }
#pragma unroll
    for (int b = 0; b < 16; ++b) F.MODP[(size_t)(ks * 16 + b) * (6 * DM) + cb * 64 + lane] = acc[b];
    LDS_WAIT(); asm volatile("" ::: "memory");
}
__device__ __forceinline__ void sincos_d(double a, float& cs, float& sn) {
    const double TWO_PI = 6.283185307179586476925286766559, INV_2PI = 0.15915494309189533576888376337251;
    const double n = __builtin_rint(a * INV_2PI); const double r = a - n * TWO_PI, r2 = r * r;
    double s = 1.0, c = 1.0;
#pragma unroll
    for (int k = 14; k >= 1; --k) { s = 1.0 - s * r2 / (double)((2 * k) * (2 * k + 1)); c = 1.0 - c * r2 / (double)((2 * k - 1) * (2 * k)); }
    sn = (float)(s * r); cs = (float)c;
}
__device__ __forceinline__ void p0_prologue(Frame& F) {
    LAS float* scr = (LAS float*)(F.lds + RING_OFF + F.wave * 16384);
    const int gw = F.vcu * NWAVES + F.wave, NGW = F.G * NWAVES;
    constexpr int I_ADA = 96 * 8;
    constexpr int I_IN = (DM / 64) * ((IN_COLS + 31) / 32), I_OUT = (DM / 64) * (DM / 32), I_G = (DM / 64) * (DFF / 32), I_DN = (DFF / 64) * (DM / 32);
    constexpr int NITEMS = I_ADA + I_IN + I_OUT + 2 * I_G + I_DN;
    for (int it = gw; it < NITEMS; it += NGW) {
        int r = it;
        if (r < I_ADA) { p0_ada_item(F, scr, r); continue; } r -= I_ADA;
        if (r < I_IN) { p0_transpose_item<1>(F.w_in, DM, IN_COLS, F.WIN, scr, r, F.lane); continue; } r -= I_IN;
        if (r < I_OUT) { p0_transpose_item<0>(F.w_out, DM, DM, F.WOUT, scr, r, F.lane); continue; } r -= I_OUT;
        if (r < I_G) { p0_transpose_item<2, FFN_BF>(F.w_gate, DM, DFF, F.WGU, scr, r, F.lane); continue; } r -= I_G;
        if (r < I_G) { p0_transpose_item<3, FFN_BF>(F.w_up, DM, DFF, F.WGU, scr, r, F.lane); continue; } r -= I_G;
        p0_transpose_item<0, FFN_BF>(F.w_down, DFF, DM, F.WDN, scr, r, F.lane);
    }
    { const int gt = F.vcu * (NWAVES * 64) + F.tid, NT = F.G * NWAVES * 64;
      for (int i = gt; i < 88 * 128; i += NT) *(u32x4*)(F.WIN + (size_t)680 * DM + (size_t)i * 8) = (u32x4){0u, 0u, 0u, 0u};
      const float invf[8] = {1.0f, 0x1.8d275ep-3f, 0x1.341190p-5f, 0x1.ddee9cp-8f, 0x1.72ba44p-10f, 0x1.1f91f0p-12f, 0x1.be218ap-15f, 0x1.5a0f50p-17f};
      for (int e = gt; e < SEQ * 8; e += NT) { const int t = e >> 3, i = e & 7; float fi = invf[0];
#pragma unroll
          for (int k = 1; k < 8; ++k) fi = (i == k) ? invf[k] : fi;
          const float ang = (float)t * fi; float cs, sn; sincos_d((double)ang, cs, sn); *(f32x2*)(F.ROPE + (size_t)e * 2) = (f32x2){cs, sn}; } }
}
__device__ __forceinline__ void p1_modulate(Frame& F) {
    LAS float* tab = (LAS float*)(F.lds + RING_OFF);
    { const int gt = F.vcu * (NWAVES * 64) + F.tid, NT = F.G * NWAVES * 64;
      for (int e = gt; e < 16 * 6 * DM; e += NT) { const int col = e % (6 * DM); float s = F.b_ada[col];
#pragma unroll
          for (int ks = 0; ks < 8; ++ks) s += F.MODP[(size_t)ks * (16 * 6 * DM) + e];
          F.MOD[e] = s; } }
    for (int blk = F.vcu; blk < MTOK / 256; blk += F.G) {
        const int b = blk / (SEQ / 256);
        __syncthreads();
        for (int e = F.tid; e < 2048; e += NWAVES * 64) { float s = F.b_ada[e];
#pragma unroll
            for (int ks = 0; ks < 8; ++ks) s += F.MODP[(size_t)(ks * 16 + b) * (6 * DM) + e];
            tab[e] = s; }
        __syncthreads();
        for (int rr = 0; rr < 32; rr += 4) { const size_t m = (size_t)blk * 256 + F.wave * 32 + rr;
            f32x4 v[4][4];
#pragma unroll
            for (int r = 0; r < 4; ++r) { const f32x4* xr = (const f32x4*)(F.x + (m + r) * DM) + F.lane;
#pragma unroll
                for (int j = 0; j < 4; ++j) v[r][j] = xr[64 * j]; }
#pragma unroll
            for (int j = 0; j < 4; ++j) { const int col = 4 * (F.lane + 64 * j);
                const f32x4 sh = *(const LAS f32x4*)(tab + col), sc = *(const LAS f32x4*)(tab + 1024 + col) + 1.0f;
#pragma unroll
                for (int r = 0; r < 4; ++r) { const f32x4 h = v[r][j] * sc + sh; u32x2 w; w.x = pkh(h[0], h[1]); w.y = pkh(h[2], h[3]); ((u32x2*)(F.XN + (m + r) * DM) + F.lane)[64 * j] = w; } } }
    }
}
template <int MODE> __device__ __forceinline__ void ln_rows(Frame& F, const f16_t* Y, const float* g, const float* bb) {
    const int gw = F.vcu * NWAVES + F.wave, NGW = F.G * NWAVES;
    f32x4 gv[2][2], bv[2][2];
#pragma unroll
    for (int j = 0; j < 2; ++j)
#pragma unroll
        for (int h = 0; h < 2; ++h) { const int col = 8 * (F.lane + 64 * j) + 4 * h; gv[j][h] = *(const f32x4*)(g + col); bv[j][h] = *(const f32x4*)(bb + col); }
    for (int m0 = gw; m0 < MTOK; m0 += 2 * NGW) {
        u32x4 raw[2][2];
#pragma unroll
        for (int r = 0; r < 2; ++r) { const int m = m0 + r * NGW; const u32x4* yr = (const u32x4*)(Y + (size_t)(m < MTOK ? m : m0) * DM) + F.lane; raw[r][0] = yr[0]; raw[r][1] = yr[64]; }
#pragma unroll
        for (int r = 0; r < 2; ++r) { const int m = m0 + r * NGW; if (m >= MTOK) break;
        f32x4 v[2][2]; float s = 0.f;
#pragma unroll
        for (int j = 0; j < 2; ++j) { const f16x8 hv = __builtin_bit_cast(f16x8, raw[r][j]);
            v[j][0] = (f32x4){(float)hv[0], (float)hv[1], (float)hv[2], (float)hv[3]}; v[j][1] = (f32x4){(float)hv[4], (float)hv[5], (float)hv[6], (float)hv[7]};
            s += ((v[j][0][0] + v[j][0][1]) + (v[j][0][2] + v[j][0][3])) + ((v[j][1][0] + v[j][1][1]) + (v[j][1][2] + v[j][1][3])); }
        const float mean = wave_sum(s) * (1.f / DM); float s2 = 0.f;
#pragma unroll
        for (int j = 0; j < 2; ++j)
#pragma unroll
            for (int h = 0; h < 2; ++h) { v[j][h] = v[j][h] - mean; s2 += (v[j][h][0] * v[j][h][0] + v[j][h][1] * v[j][h][1]) + (v[j][h][2] * v[j][h][2] + v[j][h][3] * v[j][h][3]); }
        const float rstd = 1.0f / sqrtf(wave_sum(s2) * (1.f / DM) + EPS);
        if (MODE == 0) {
            const int b = m / SEQ; const float* md = F.MOD + (size_t)b * (6 * DM);
            u32x4* x1r = (u32x4*)(F.X1H + (size_t)m * DM) + F.lane; u32x4* xo = (u32x4*)(F.XN + (size_t)m * DM) + F.lane;
#pragma unroll
            for (int j = 0; j < 2; ++j) { f32x4 x1[2], hh[2];
#pragma unroll
                for (int h = 0; h < 2; ++h) { const int col = 8 * (F.lane + 64 * j) + 4 * h; x1[h] = v[j][h] * rstd * gv[j][h] + bv[j][h];
                    const f32x4 sh = *(const f32x4*)(md + 3 * DM + col), sc = *(const f32x4*)(md + 4 * DM + col); hh[h] = x1[h] * (sc + 1.0f) + sh; }
                u32x4 w; w.x = pkh(x1[0][0], x1[0][1]); w.y = pkh(x1[0][2], x1[0][3]); w.z = pkh(x1[1][0], x1[1][1]); w.w = pkh(x1[1][2], x1[1][3]); x1r[64 * j] = w;
                u32x4 q; if (FFN_BF) { q.x = pkb(hh[0][0], hh[0][1]); q.y = pkb(hh[0][2], hh[0][3]); q.z = pkb(hh[1][0], hh[1][1]); q.w = pkb(hh[1][2], hh[1][3]); }
                else { q.x = pkh(hh[0][0], hh[0][1]); q.y = pkh(hh[0][2], hh[0][3]); q.z = pkh(hh[1][0], hh[1][1]); q.w = pkh(hh[1][2], hh[1][3]); } xo[64 * j] = q; }
        } else {
            float* orow = F.out + (size_t)m * DM;
#pragma unroll
            for (int j = 0; j < 2; ++j)
#pragma unroll
                for (int h = 0; h < 2; ++h) { const int col = 8 * (F.lane + 64 * j) + 4 * h; *(f32x4*)(orow + col) = v[j][h] * rstd * gv[j][h] + bv[j][h]; }
        }
        }
    }
}

__device__ __forceinline__ f32x4 mfma16(f16x8 a, f16x8 b, f32x4 c) { return __builtin_amdgcn_mfma_f32_16x16x32_f16(a, b, c, 0, 0, 0); }
__device__ __forceinline__ f32x16 mfma32(f16x8 a, f16x8 b, f32x16 c) { return __builtin_amdgcn_mfma_f32_32x32x16_f16(a, b, c, 0, 0, 0); }
__device__ __forceinline__ int wave_sum_i(int v) { return __builtin_amdgcn_readfirstlane(__reduce_add_sync(~0ull, v)); }

__device__ __forceinline__ void conv_rows(Frame& F) {
    const int gw = F.vcu * NWAVES + F.wave, NGW = F.G * NWAVES, lane = F.lane;
    float w0[8], w1[8], w2[8], gn[8];
#pragma unroll
    for (int e = 0; e < 8; ++e) { w0[e] = F.conv_w[8 * lane + e]; w1[e] = F.conv_w[CW + 8 * lane + e]; w2[e] = F.conv_w[2 * CW + 8 * lane + e]; gn[e] = F.conv_g[8 * lane + e]; }
    for (int m = gw; m < MTOK; m += NGW) {
        const int t = m & (SEQ - 1);
        const f16x8 z = {0, 0, 0, 0, 0, 0, 0, 0};
        const f16x8 u0 = *(const f16x8*)(F.U + (size_t)m * CW + 8 * lane);
        const f16x8 u1 = t >= 1 ? *(const f16x8*)(F.U + (size_t)(m - 1) * CW + 8 * lane) : z;
        const f16x8 u2 = t >= 2 ? *(const f16x8*)(F.U + (size_t)(m - 2) * CW + 8 * lane) : z;
        const f16x8 gb = *(const f16x8*)(F.GB + (size_t)m * CW + 8 * lane);
        float y[8]; float ss = 0.f;
#pragma unroll
        for (int e = 0; e < 8; ++e) { const float cv = w0[e] * (float)u2[e] + w1[e] * (float)u1[e] + w2[e] * (float)u0[e]; y[e] = (float)gb[e] * cv; ss += y[e] * y[e]; }
        ss += __shfl_xor(ss, 1); ss += __shfl_xor(ss, 2); ss += __shfl_xor(ss, 4);
        const float rstd = 1.0f / sqrtf(ss * (1.f / 64.f) + EPS);
        u32x4 o; o.x = pkh(y[0] * rstd * gn[0], y[1] * rstd * gn[1]); o.y = pkh(y[2] * rstd * gn[2], y[3] * rstd * gn[3]);
        o.z = pkh(y[4] * rstd * gn[4], y[5] * rstd * gn[5]); o.w = pkh(y[6] * rstd * gn[6], y[7] * rstd * gn[7]);
        *(u32x4*)(F.MIX + (size_t)m * DM + AW + 8 * lane) = o;
    }
}

__device__ __forceinline__ void conv_row_one(Frame& F, int m, int lane) {
    const int t = m & (SEQ - 1);
    const f16x8 z = {0, 0, 0, 0, 0, 0, 0, 0};
    const f16x8 u0 = *(const f16x8*)(F.U + (size_t)m * CW + 8 * lane);
    const f16x8 u1 = t >= 1 ? *(const f16x8*)(F.U + (size_t)(m - 1) * CW + 8 * lane) : z;
    const f16x8 u2 = t >= 2 ? *(const f16x8*)(F.U + (size_t)(m - 2) * CW + 8 * lane) : z;
    const f16x8 gb = *(const f16x8*)(F.GB + (size_t)m * CW + 8 * lane);
    const f32x4 w0a = *(const f32x4*)(F.conv_w + 8 * lane), w0b = *(const f32x4*)(F.conv_w + 8 * lane + 4), w1a = *(const f32x4*)(F.conv_w + CW + 8 * lane), w1b = *(const f32x4*)(F.conv_w + CW + 8 * lane + 4);
    const f32x4 w2a = *(const f32x4*)(F.conv_w + 2 * CW + 8 * lane), w2b = *(const f32x4*)(F.conv_w + 2 * CW + 8 * lane + 4), gna = *(const f32x4*)(F.conv_g + 8 * lane), gnb = *(const f32x4*)(F.conv_g + 8 * lane + 4);
    float y[8]; float ss = 0.f;
#pragma unroll
    for (int e = 0; e < 8; ++e) { const float a0 = e < 4 ? w0a[e & 3] : w0b[e & 3], a1 = e < 4 ? w1a[e & 3] : w1b[e & 3], a2 = e < 4 ? w2a[e & 3] : w2b[e & 3];
        const float cv = a0 * (float)u2[e] + a1 * (float)u1[e] + a2 * (float)u0[e]; y[e] = (float)gb[e] * cv; ss += y[e] * y[e]; }
    ss += __shfl_xor(ss, 1); ss += __shfl_xor(ss, 2); ss += __shfl_xor(ss, 4);
    const float rstd = 1.0f / sqrtf(ss * (1.f / 64.f) + EPS);
    u32x4 o; o.x = pkh(y[0] * rstd * gna[0], y[1] * rstd * gna[1]); o.y = pkh(y[2] * rstd * gna[2], y[3] * rstd * gna[3]);
    o.z = pkh(y[4] * rstd * gnb[0], y[5] * rstd * gnb[1]); o.w = pkh(y[6] * rstd * gnb[2], y[7] * rstd * gnb[3]);
    *(u32x4*)(F.MIX + (size_t)m * DM + AW + 8 * lane) = o;
}

#define SEL_COUNT(res, ni, PRED) do { int c_ = 0; \
    _Pragma("unroll") for (int i = 0; i < 16; ++i) c_ += (PRED(u[i], 64 * i + lane)) ? 1 : 0; \
    if ((ni) > 16) { _Pragma("unroll") for (int i = 16; i < 32; ++i) c_ += (PRED(u[i], 64 * i + lane)) ? 1 : 0; } \
    if ((ni) > 32) { _Pragma("unroll") for (int i = 32; i < 48; ++i) c_ += (PRED(u[i], 64 * i + lane)) ? 1 : 0; } \
    if ((ni) > 48) { _Pragma("unroll") for (int i = 48; i < 64; ++i) c_ += (PRED(u[i], 64 * i + lane)) ? 1 : 0; } \
    res = wave_sum_i(c_); } while (0)

__device__ __forceinline__ unsigned long long cmp_ge_mask(unsigned x, unsigned c) { unsigned long long m; asm("v_cmp_ge_u32_e64 %0, %1, %2" : "=s"(m) : "v"(x), "s"(c)); return m; }
__device__ __forceinline__ void addc_mask(int& acc, unsigned long long m) { unsigned long long co_; asm("v_addc_co_u32_e64 %0, %1, 0, %0, %2" : "+v"(acc), "=s"(co_) : "s"(m)); }
#define GE2_BLOCK8(a0, a1, base, cand) do { unsigned long long t0_, t1_, t2_, t3_, t4_, t5_, t6_, t7_; \
    asm("v_cmp_ge_u32_e64 %2, %10, %18\n\tv_cmp_ge_u32_e64 %3, %11, %18\n\tv_cmp_ge_u32_e64 %4, %12, %18\n\tv_cmp_ge_u32_e64 %5, %13, %18\n\t" \
        "v_cmp_ge_u32_e64 %6, %14, %18\n\tv_cmp_ge_u32_e64 %7, %15, %18\n\tv_cmp_ge_u32_e64 %8, %16, %18\n\tv_cmp_ge_u32_e64 %9, %17, %18\n\t" \
        "v_addc_co_u32_e64 %0, %2, 0, %0, %2\n\tv_addc_co_u32_e64 %1, %3, 0, %1, %3\n\tv_addc_co_u32_e64 %0, %4, 0, %0, %4\n\tv_addc_co_u32_e64 %1, %5, 0, %1, %5\n\t" \
        "v_addc_co_u32_e64 %0, %6, 0, %0, %6\n\tv_addc_co_u32_e64 %1, %7, 0, %1, %7\n\tv_addc_co_u32_e64 %0, %8, 0, %0, %8\n\tv_addc_co_u32_e64 %1, %9, 0, %1, %9" \
        : "+v"(a0), "+v"(a1), "=&s"(t0_), "=&s"(t1_), "=&s"(t2_), "=&s"(t3_), "=&s"(t4_), "=&s"(t5_), "=&s"(t6_), "=&s"(t7_) \
        : "v"(u[(base) + 0]), "v"(u[(base) + 1]), "v"(u[(base) + 2]), "v"(u[(base) + 3]), "v"(u[(base) + 4]), "v"(u[(base) + 5]), "v"(u[(base) + 6]), "v"(u[(base) + 7]), "s"(cand)); } while (0)
#define SEL_COUNT_GE2(res, ni, cand) do { int a0_ = 0, a1_ = 0; GE2_BLOCK8(a0_, a1_, 0, cand); GE2_BLOCK8(a0_, a1_, 8, cand); \
    if ((ni) > 16) { GE2_BLOCK8(a0_, a1_, 16, cand); GE2_BLOCK8(a0_, a1_, 24, cand); } \
    if ((ni) > 32) { GE2_BLOCK8(a0_, a1_, 32, cand); GE2_BLOCK8(a0_, a1_, 40, cand); } \
    if ((ni) > 48) { GE2_BLOCK8(a0_, a1_, 48, cand); GE2_BLOCK8(a0_, a1_, 56, cand); } \
    res = wave_sum_i(a0_ + a1_); } while (0)

#define GE3_BLOCK8(a0, a1, base, cm1) do { unsigned t0_, t1_, t2_, t3_, t4_, t5_, t6_, t7_; \
    asm("v_sub_u32_e64 %2, %10, %18 clamp\n\tv_sub_u32_e64 %3, %11, %18 clamp\n\tv_sub_u32_e64 %4, %12, %18 clamp\n\tv_sub_u32_e64 %5, %13, %18 clamp\n\t" \
        "v_sub_u32_e64 %6, %14, %18 clamp\n\tv_sub_u32_e64 %7, %15, %18 clamp\n\tv_sub_u32_e64 %8, %16, %18 clamp\n\tv_sub_u32_e64 %9, %17, %18 clamp\n\t" \
        "v_min_u32_e32 %2, 1, %2\n\tv_min_u32_e32 %3, 1, %3\n\tv_min_u32_e32 %4, 1, %4\n\tv_min_u32_e32 %5, 1, %5\n\t" \
        "v_min_u32_e32 %6, 1, %6\n\tv_min_u32_e32 %7, 1, %7\n\tv_min_u32_e32 %8, 1, %8\n\tv_min_u32_e32 %9, 1, %9\n\t" \
        "v_add3_u32 %0, %2, %3, %0\n\tv_add3_u32 %1, %4, %5, %1\n\tv_add3_u32 %0, %6, %7, %0\n\tv_add3_u32 %1, %8, %9, %1" \
        : "+v"(a0), "+v"(a1), "=&v"(t0_), "=&v"(t1_), "=&v"(t2_), "=&v"(t3_), "=&v"(t4_), "=&v"(t5_), "=&v"(t6_), "=&v"(t7_) \
        : "v"(u[(base) + 0]), "v"(u[(base) + 1]), "v"(u[(base) + 2]), "v"(u[(base) + 3]), "v"(u[(base) + 4]), "v"(u[(base) + 5]), "v"(u[(base) + 6]), "v"(u[(base) + 7]), "s"(cm1)); } while (0)
#define SEL_COUNT_GE3(res, ni, cand) do { int a0_ = 0, a1_ = 0; const unsigned cm1_ = (cand) - 1u; GE3_BLOCK8(a0_, a1_, 0, cm1_); GE3_BLOCK8(a0_, a1_, 8, cm1_); \
    if ((ni) > 16) { GE3_BLOCK8(a0_, a1_, 16, cm1_); GE3_BLOCK8(a0_, a1_, 24, cm1_); } \
    if ((ni) > 32) { GE3_BLOCK8(a0_, a1_, 32, cm1_); GE3_BLOCK8(a0_, a1_, 40, cm1_); } \
    if ((ni) > 48) { GE3_BLOCK8(a0_, a1_, 48, cm1_); GE3_BLOCK8(a0_, a1_, 56, cm1_); } \
    res = wave_sum_i(a0_ + a1_); } while (0)

__device__ __forceinline__ float bfly_max_16_32(float v) {
    auto r = __builtin_amdgcn_permlane16_swap(__float_as_uint(v), __float_as_uint(v), false, false); v = __builtin_fmaxf(__uint_as_float(r[0]), __uint_as_float(r[1]));
    auto q = __builtin_amdgcn_permlane32_swap(__float_as_uint(v), __float_as_uint(v), false, false); return __builtin_fmaxf(__uint_as_float(q[0]), __uint_as_float(q[1]));
}
__device__ __forceinline__ float bfly_sum_16_32(float v) {
    auto r = __builtin_amdgcn_permlane16_swap(__float_as_uint(v), __float_as_uint(v), false, false); v = __uint_as_float(r[0]) + __uint_as_float(r[1]);
    auto q = __builtin_amdgcn_permlane32_swap(__float_as_uint(v), __float_as_uint(v), false, false); return __uint_as_float(q[0]) + __uint_as_float(q[1]);
}
__device__ __forceinline__ unsigned wave_max_u(unsigned x) {
#define WMX_STEP(ctrl, rm, bc) do { const unsigned y_ = (unsigned)__builtin_amdgcn_update_dpp(0, (int)x, ctrl, rm, 0xf, bc); x = x > y_ ? x : y_; } while (0)
    WMX_STEP(0x111, 0xf, true); WMX_STEP(0x112, 0xf, true); WMX_STEP(0x114, 0xf, true); WMX_STEP(0x118, 0xf, true); WMX_STEP(0x142, 0xa, false); WMX_STEP(0x143, 0xc, false);
#undef WMX_STEP
    return (unsigned)__builtin_amdgcn_readlane((int)x, 63);
}
__device__ __forceinline__ int wave_prefix_incl(int x) {
    x += __builtin_amdgcn_update_dpp(0, x, 0x111, 0xf, 0xf, true);
    x += __builtin_amdgcn_update_dpp(0, x, 0x112, 0xf, 0xf, true);
    x += __builtin_amdgcn_update_dpp(0, x, 0x114, 0xf, 0xf, true);
    x += __builtin_amdgcn_update_dpp(0, x, 0x118, 0xf, 0xf, true);
    x += __builtin_amdgcn_update_dpp(0, x, 0x142, 0xa, 0xf, false);
    x += __builtin_amdgcn_update_dpp(0, x, 0x143, 0xc, 0xf, false);
    return x;
}

constexpr int VSTG_OFF = 131072;
constexpr int STASH_OFF = VSTG_OFF + 16384;
constexpr int WTAB_OFF = STASH_OFF + 4096;
constexpr int LIST_OFF = WTAB_OFF + 256;
__device__ __forceinline__ int sfx_find(int v, int need, int& ex, int& val) {
#if defined(SEL_SFX_OLD)
    const int lane_ = threadIdx.x & 63; int sfx_ = v;
#pragma unroll
    for (int o = 1; o < 64; o <<= 1) { const int tt = __shfl_down(sfx_, o); if (lane_ + o < 64) sfx_ += tt; }
    const int excl = sfx_ - v;
#else
    const int pin = wave_prefix_incl(v); const int total = __builtin_amdgcn_readlane(pin, 63);
    const int excl = total - pin;
#endif
    const bool hit = (excl < need) && (need <= excl + v);
    const unsigned long long m = __ballot(hit);
    const int Ls = m ? (int)__builtin_ctzll(m) : 0;
    ex = __builtin_amdgcn_readlane(excl, Ls); val = __builtin_amdgcn_readlane(v, Ls);
    return Ls;
}
__device__ __forceinline__ void wg_arrive(volatile LAS unsigned* cnt, int lane) { asm volatile("s_waitcnt lgkmcnt(0)" ::: "memory"); if (lane == 0) (void)__hip_atomic_fetch_add((LAS unsigned*)cnt, 1u, __ATOMIC_RELAXED, __HIP_MEMORY_SCOPE_WORKGROUP); }
__device__ __forceinline__ void wg_wait(volatile LAS unsigned* cnt, unsigned target) {
    while ((unsigned)__builtin_amdgcn_readfirstlane((int)__hip_atomic_load((LAS unsigned*)cnt, __ATOMIC_RELAXED, __HIP_MEMORY_SCOPE_WORKGROUP)) < target) __builtin_amdgcn_s_sleep(1);
    asm volatile("" ::: "memory");
}
__device__ __forceinline__ void sa_phase(Frame& F) {
    const int lane = F.lane, wave = F.wave;
    const int xcd = F.vcu >> 5, wloc = F.vcu & 31, b = 2 * xcd + (wloc >> 4), wl = wloc & 15;
    const size_t rowbase = (size_t)b * SEQ;
    LAS unsigned char* myreg = F.lds + RING_OFF + wave * 16384;
    LAS unsigned char* VT = F.lds + VSTG_OFF + wave * 2048;
    LAS float* SC = (LAS float*)(F.lds + RING_OFF);
    const f16x8 zero8 = {0, 0, 0, 0, 0, 0, 0, 0};
    f16x8 a[2][2]; f32x4 wv[2][2][2];
    LAS unsigned short* lprev = (LAS unsigned short*)(F.lds + LIST_OFF + wave * 512);
    int tprev = -1;
    const __amdgpu_buffer_rsrc_t rsK = __builtin_amdgcn_make_buffer_rsrc((void*)(F.K + rowbase * HD), 0, SEQ * HD * 2, 0x00020000);
    const __amdgpu_buffer_rsrc_t rsKI = __builtin_amdgcn_make_buffer_rsrc((void*)(F.KI + rowbase * ID), 0, SEQ * ID * 2, 0x00020000);
    const __amdgpu_buffer_rsrc_t rsV = __builtin_amdgcn_make_buffer_rsrc((void*)(F.V + rowbase * HD), 0, SEQ * HD * 2, 0x00020000);
    f16x8 bqn0 = {0, 0, 0, 0, 0, 0, 0, 0}, bqn1 = {0, 0, 0, 0, 0, 0, 0, 0};
    volatile LAS unsigned* cnt1 = F.MISC + 16; volatile LAS unsigned* cnt2 = F.MISC + 32;
    f16x8 pa_reg = zero8; float pw_reg = 0.f;
    const int rta = (wave >> 1) & 1, kca = wave & 1;
    LAS unsigned char* STASH = F.lds + STASH_OFF; LAS float* WTAB = (LAS float*)(F.lds + WTAB_OFF);
#define STASH_LOAD(T0) do { if (wave == 4) pw_reg = F.WI[(rowbase + (T0)) * IH + lane]; \
        if (wave < 4) pa_reg = *(const f16x8*)(F.QI + (rowbase + (T0) + 4 * rta + qa) * (IH * ID) + ahead * ID + 16 * kca + 8 * hi); } while (0)
#define STASH_STORE() do { if (wave == 4) WTAB[lane] = pw_reg; if (wave < 4) *(LAS f16x8*)(STASH + wave * 1024 + lane * 16) = pa_reg; } while (0)
#define KIX(g) ((int)lprev[16 * (g) + head_])
#define VIX(i) ((int)lprev[32 * ((i) >> 2) + 8 * ((i) & 3) + (ln_ >> 3)])
#define ATTN_BLOCK() do { if (tprev >= 0) { __builtin_amdgcn_s_setprio(1); \
        int ln_ = lane; asm volatile("" : "+v"(ln_));     \
        const int head_ = ln_ & 15, q4_ = ln_ >> 4; \
        const int t = tprev; const int cnt_sel = (t + 1) < TOPK ? (t + 1) : TOPK; \
        const f16x8 bq0 = bqn0, bq1 = bqn1; \
        f32x4 s[16]; \
        _Pragma("unroll") for (int qtr = 0; qtr < 4; ++qtr) {     \
            u32x4 kr[4][2]; \
            _Pragma("unroll") for (int g = 0; g < 4; ++g) \
                _Pragma("unroll") for (int rep = 0; rep < 2; ++rep) kr[g][rep] = __builtin_amdgcn_raw_buffer_load_b128(rsK, (int)lprev[16 * (4 * qtr + g) + 8 * rep + (ln_ >> 3)] * (HD * 2) + 16 * (ln_ & 7), 0, 0); \
            _Pragma("unroll") for (int g = 0; g < 4; ++g) { \
                _Pragma("unroll") for (int rep = 0; rep < 2; ++rep) { const int pl = 8 * rep + (ln_ >> 3), ch = ln_ & 7; *(LAS u32x4*)(VT + pl * 128 + 16 * (ch ^ ((pl >> 1) & 7))) = kr[g][rep]; } \
                const int r_ = ln_ & 15; \
                const f16x8 ak0 = *(const LAS f16x8*)(VT + r_ * 128 + 16 * (q4_ ^ ((r_ >> 1) & 7))), ak1 = *(const LAS f16x8*)(VT + r_ * 128 + 16 * ((q4_ + 4) ^ ((r_ >> 1) & 7))); \
                f32x4 c = {0.f, 0.f, 0.f, 0.f}; c = mfma16(ak0, bq0, c); c = mfma16(ak1, bq1, c); s[4 * qtr + g] = c; } \
        } \
        u32x4 vr[2][4]; \
        _Pragma("unroll") for (int cc = 0; cc < 2; ++cc) \
            _Pragma("unroll") for (int rep = 0; rep < 4; ++rep) vr[cc][rep] = __builtin_amdgcn_raw_buffer_load_b128(rsV, VIX(4 * cc + rep) * (HD * 2) + 16 * (ln_ & 7), 0, 0); \
        if (cnt_sel < TOPK) { const int thr2 = cnt_sel - 4 * q4_; \
            _Pragma("unroll") for (int g = 0; g < 16; ++g) \
                _Pragma("unroll") for (int e = 0; e < 4; ++e) if (16 * g + e >= thr2) s[g][e] = -INFINITY; \
        } \
        float mx = s[0][0]; \
        _Pragma("unroll") for (int g = 0; g < 16; ++g) \
            _Pragma("unroll") for (int e = 0; e < 4; ++e) mx = __builtin_fmaxf(mx, s[g][e]); \
        mx = bfly_max_16_32(mx); \
        float l = 0.f; \
        _Pragma("unroll") for (int g = 0; g < 16; ++g) \
            _Pragma("unroll") for (int e = 0; e < 4; ++e) { const float pv = __builtin_amdgcn_exp2f(s[g][e] - mx); s[g][e] = pv; l += pv; } \
        l = bfly_sum_16_32(l); \
        f32x4 o[4]; \
        _Pragma("unroll") for (int dt = 0; dt < 4; ++dt) o[dt] = (f32x4){0.f, 0.f, 0.f, 0.f}; \
        _Pragma("unroll") for (int c = 0; c < 8; ++c) { \
            _Pragma("unroll") for (int rd = 0; rd < 2; ++rd) { \
                _Pragma("unroll") for (int r2 = 0; r2 < 2; ++r2) { const int pl = 8 * r2 + (ln_ >> 3), ch = ln_ & 7; \
                    *(LAS u32x4*)(VT + pl * 128 + 16 * (ch ^ (2 * ((pl >> 1) & 3)))) = vr[c & 1][2 * rd + r2]; } \
                v4i16_t tr[4]; \
                _Pragma("unroll") for (int dt = 0; dt < 4; ++dt) { const int R = 4 * q4_ + ((ln_ & 15) >> 2), pp = ln_ & 3, chunk = 2 * dt + (pp >> 1); \
                    tr[dt] = __builtin_amdgcn_ds_read_tr16_b64_v4i16((LAS v4i16_t*)(VT + R * 128 + 16 * (chunk ^ (2 * ((R >> 1) & 3))) + 8 * (pp & 1))); } \
                const f32x4 pa = s[2 * c + rd]; u32x2 w; w.x = pkh(pa[0], pa[1]); w.y = pkh(pa[2], pa[3]); const f16x4 bp = __builtin_bit_cast(f16x4, w); \
                _Pragma("unroll") for (int dt = 0; dt < 4; ++dt) o[dt] = __builtin_amdgcn_mfma_f32_16x16x16f16(__builtin_bit_cast(f16x4, tr[dt]), bp, o[dt], 0, 0, 0); \
            } \
            if (c < 6) { \
                _Pragma("unroll") for (int rep = 0; rep < 4; ++rep) vr[c & 1][rep] = __builtin_amdgcn_raw_buffer_load_b128(rsV, VIX(4 * (c + 2) + rep) * (HD * 2) + 16 * (ln_ & 7), 0, 0); \
            } \
        } \
        const float inv_l = 1.0f / l; float ss = 0.f; \
        _Pragma("unroll") for (int dt = 0; dt < 4; ++dt) { o[dt] = o[dt] * inv_l; ss += (o[dt][0] * o[dt][0] + o[dt][1] * o[dt][1]) + (o[dt][2] * o[dt][2] + o[dt][3] * o[dt][3]); } \
        ss = bfly_sum_16_32(ss); \
        const float rstd = 1.0f / sqrtf(ss * (1.f / 64.f) + EPS); \
        if (head_ < NH) { \
            _Pragma("unroll") for (int dt = 0; dt < 4; ++dt) { const int col = head_ * HD + 16 * dt + 4 * q4_; const f32x4 gn = *(const f32x4*)(F.attn_g + col); \
                const f32x4 y = o[dt] * rstd * gn; u32x2 w; w.x = pkh(y[0], y[1]); w.y = pkh(y[2], y[3]); \
                *(u32x2*)(F.MIX + (rowbase + t) * DM + col) = w; } \
        } __builtin_amdgcn_s_setprio(0); } } while (0)

    { const int c31 = lane & 31, hi = lane >> 5, g_ = c31 >> 3, hp_ = (c31 >> 2) & 1, jj_ = c31 & 3, qa = 2 * hp_ + (g_ >> 1), ahead = 4 * (g_ & 1) + jj_;
      STASH_LOAD(8 * wl); STASH_STORE(); }
    asm volatile("s_waitcnt lgkmcnt(0)\n\ts_barrier" ::: "memory");
    for (int it = 0; it < 32; ++it) {
        const int p = wl + 16 * (it >> 1); const int qg = (it & 1) ? 511 - p : p;
        const int t0 = 8 * qg;
        int lr_ = lane; asm volatile("" : "+v"(lr_));
        const int c31 = lr_ & 31, hi = lr_ >> 5, g_ = c31 >> 3, hp_ = (c31 >> 2) & 1, jj_ = c31 & 3, qa = 2 * hp_ + (g_ >> 1), ahead = 4 * (g_ & 1) + jj_;
        {
            const int ntiles = (t0 + 8 + 31) >> 5;
            if (it > 0) wg_wait(cnt2, 8u * (unsigned)it);
#pragma unroll
            for (int rt = 0; rt < 2; ++rt) {
#pragma unroll
                for (int kc = 0; kc < 2; ++kc) a[rt][kc] = *(const LAS f16x8*)(STASH + (rt * 2 + kc) * 1024 + lane * 16);
#pragma unroll
                for (int qq = 0; qq < 2; ++qq)
#pragma unroll
                    for (int h = 0; h < 2; ++h) wv[rt][qq][h] = *(const LAS f32x4*)(WTAB + (4 * rt + 2 * hi + qq) * 8 + 4 * h); }
            volatile LAS unsigned* tcnt = F.MISC + 48 + 4 * (it & 1);
            for (;;) {
                unsigned g0_ = 0u; if (lane == 0) g0_ = __hip_atomic_fetch_add((LAS unsigned*)tcnt, 4u, __ATOMIC_RELAXED, __HIP_MEMORY_SCOPE_WORKGROUP);
                const int k0 = __builtin_amdgcn_readfirstlane((int)g0_);
#if defined(SEL16)
                if (k0 >= ((ntiles + 3) & ~3)) break;
#pragma unroll
                for (int i = 0; i < 4; ++i) { const int kt = k0 + i;
                    if (kt >= ntiles) {
#pragma unroll
                        for (int rq = 0; rq < 4; ++rq) ((LAS unsigned short*)SC)[((rq >> 1) * 4 + 2 * hi + (rq & 1)) * 8192 + 32 * kt + c31] = (unsigned short)0; } }
                if (k0 >= ntiles) continue;
#else
                if (k0 >= ntiles) break;
#endif
                f16x8 bt[4][2];
#pragma unroll
                for (int i = 0; i < 4; ++i) { int kt = k0 + i; kt = kt < ntiles ? kt : ntiles - 1;
                    bt[i][0] = __builtin_bit_cast(f16x8, __builtin_amdgcn_raw_buffer_load_b128(rsKI, c31 * (ID * 2) + 16 * hi, kt * (32 * ID * 2), 0));
                    bt[i][1] = __builtin_bit_cast(f16x8, __builtin_amdgcn_raw_buffer_load_b128(rsKI, c31 * (ID * 2) + 16 * hi + 32, kt * (32 * ID * 2), 0)); }
                f32x16 cc[2];
                { const f32x16 z16 = {0.f, 0.f, 0.f, 0.f, 0.f, 0.f, 0.f, 0.f, 0.f, 0.f, 0.f, 0.f, 0.f, 0.f, 0.f, 0.f}; cc[0] = mfma32(a[0][0], bt[0][0], z16); cc[0] = mfma32(a[0][1], bt[0][1], cc[0]); }
#pragma unroll
                for (int u = 0; u < 8; ++u) { const int i = u >> 1, rt = u & 1, kt = k0 + i;
                    if (u + 1 < 8) { const int i2 = (u + 1) >> 1, rt2 = (u + 1) & 1; const f32x16 z16 = {0.f, 0.f, 0.f, 0.f, 0.f, 0.f, 0.f, 0.f, 0.f, 0.f, 0.f, 0.f, 0.f, 0.f, 0.f, 0.f};
                        cc[(u + 1) & 1] = mfma32(a[rt2][0], bt[i2][0], z16); cc[(u + 1) & 1] = mfma32(a[rt2][1], bt[i2][1], cc[(u + 1) & 1]); }
                    if (kt < ntiles) { const f32x16 c = cc[u & 1];
#pragma unroll
                            for (int qq = 0; qq < 2; ++qq) { f32x2 s2 = {0.f, 0.f};
#pragma unroll
                                for (int hp = 0; hp < 4; ++hp) { const float cf0 = c[8 * qq + 2 * hp], cf1 = c[8 * qq + 2 * hp + 1]; const int ci0 = __float_as_int(cf0), ci1 = __float_as_int(cf1);
                                    const f32x2 r2 = {__int_as_float(ci0 > 0 ? ci0 : 0), __int_as_float(ci1 > 0 ? ci1 : 0)}; const f32x2 w2 = {wv[rt][qq][hp >> 1][2 * (hp & 1)], wv[rt][qq][hp >> 1][2 * (hp & 1) + 1]};
                                    s2 = __builtin_elementwise_fma(r2, w2, s2); }
                                const float s = s2[0] + s2[1];
                                int qv_ = (int)__builtin_fmaf(s, 2048.0f, 32768.5f); qv_ = qv_ < 1 ? 1 : (qv_ > 65535 ? 65535 : qv_);
                                if (kt == ntiles - 1 && 32 * kt + c31 > t0 + 4 * rt + 2 * hi + qq) qv_ = 0;
                                ((LAS unsigned short*)SC)[(4 * rt + 2 * hi + qq) * 8192 + 32 * kt + c31] = (unsigned short)qv_; }
                    }
                }
            }
        }
        wg_arrive(cnt1, lane);
        if (it + 1 < 32) { const int p2 = wl + 16 * ((it + 1) >> 1); const int qg2 = ((it + 1) & 1) ? 511 - p2 : p2; STASH_LOAD(8 * qg2); }
        if (wave >= 4) ATTN_BLOCK();
        const int tcur = t0 + wave;
        while ((unsigned)__builtin_amdgcn_readfirstlane((int)__hip_atomic_load((LAS unsigned*)cnt1, __ATOMIC_RELAXED, __HIP_MEMORY_SCOPE_WORKGROUP)) < 8u * (unsigned)(it + 1)) {
            unsigned g1_ = 0u; if (lane == 0) g1_ = __hip_atomic_fetch_add((LAS unsigned*)(F.MISC + 56), 1u, __ATOMIC_RELAXED, __HIP_MEMORY_SCOPE_WORKGROUP);
            const int cr = __builtin_amdgcn_readfirstlane((int)g1_);
            if (cr < 256) conv_row_one(F, F.vcu * 256 + cr, lane); else __builtin_amdgcn_s_sleep(1);
        }
        asm volatile("" ::: "memory");
        STASH_STORE();
        if (wave == 0 && lane == 0) F.MISC[48 + 4 * ((it + 1) & 1)] = 0u;
        LAS unsigned short* IDX = (LAS unsigned short*)(F.lds + LIST_OFF + ((it & 1) * 8 + wave) * 512);
#if defined(SEL16)
        {
            const int n = tcur + 1, nr = (t0 + 8 + 127) >> 7;
            unsigned x[32];
            { const LAS unsigned* S = (const LAS unsigned*)myreg;
#pragma unroll
              for (int i = 0; i < 32; ++i) { const unsigned v_ = S[64 * i + lane]; x[i] = (i < nr) ? v_ : 0u; } }
            asm volatile("" :: "v"(x[0]), "v"(x[7]), "v"(x[15]), "v"(x[31]) : "memory");
            wg_arrive(cnt2, lane);
#define P16_BLOCK8(a0, a1, base, cs) do { unsigned t0_, t1_, t2_, t3_, t4_, t5_, t6_, t7_; \
    asm("v_pk_sub_u16 %2, %10, %18 clamp\n\tv_pk_sub_u16 %3, %11, %18 clamp\n\tv_pk_sub_u16 %4, %12, %18 clamp\n\tv_pk_sub_u16 %5, %13, %18 clamp\n\t" \
        "v_pk_sub_u16 %6, %14, %18 clamp\n\tv_pk_sub_u16 %7, %15, %18 clamp\n\tv_pk_sub_u16 %8, %16, %18 clamp\n\tv_pk_sub_u16 %9, %17, %18 clamp\n\t" \
        "v_pk_min_u16 %2, %2, %19\n\tv_pk_min_u16 %3, %3, %19\n\tv_pk_min_u16 %4, %4, %19\n\tv_pk_min_u16 %5, %5, %19\n\t" \
        "v_pk_min_u16 %6, %6, %19\n\tv_pk_min_u16 %7, %7, %19\n\tv_pk_min_u16 %8, %8, %19\n\tv_pk_min_u16 %9, %9, %19\n\t" \
        "v_pk_add_u16 %0, %0, %2\n\tv_pk_add_u16 %1, %1, %3\n\tv_pk_add_u16 %0, %0, %4\n\tv_pk_add_u16 %1, %1, %5\n\t" \
        "v_pk_add_u16 %0, %0, %6\n\tv_pk_add_u16 %1, %1, %7\n\tv_pk_add_u16 %0, %0, %8\n\tv_pk_add_u16 %1, %1, %9" \
        : "+v"(a0), "+v"(a1), "=&v"(t0_), "=&v"(t1_), "=&v"(t2_), "=&v"(t3_), "=&v"(t4_), "=&v"(t5_), "=&v"(t6_), "=&v"(t7_) \
        : "v"(x[(base) + 0]), "v"(x[(base) + 1]), "v"(x[(base) + 2]), "v"(x[(base) + 3]), "v"(x[(base) + 4]), "v"(x[(base) + 5]), "v"(x[(base) + 6]), "v"(x[(base) + 7]), "s"(cs), "v"(one2)); } while (0)
#define P16_COUNT(res, cand) do { unsigned a0_ = 0u, a1_ = 0u; const unsigned cs_ = ((cand) - 1u) * 0x00010001u; \
    P16_BLOCK8(a0_, a1_, 0, cs_); if (nr > 8) P16_BLOCK8(a0_, a1_, 8, cs_); if (nr > 16) P16_BLOCK8(a0_, a1_, 16, cs_); if (nr > 24) P16_BLOCK8(a0_, a1_, 24, cs_); \
    const unsigned aa_ = a0_ + a1_; res = __builtin_amdgcn_readlane(wave_prefix_incl((int)((aa_ & 0xffffu) + (aa_ >> 16))), 63); } while (0)
            const unsigned one2 = 0x00010001u;
            unsigned T16 = 0u; int r = 0;
            if (n > TOPK) {
                unsigned mp = x[0];
#pragma unroll
                for (int i = 1; i < 32; ++i) asm("v_pk_max_u16 %0, %0, %1" : "+v"(mp) : "v"(x[i]));
                const unsigned mx = wave_max_u((mp & 0xffffu) > (mp >> 16) ? (mp & 0xffffu) : (mp >> 16));
                unsigned Tacc = 0u; bool exact = false;
                for (int bit = 31 - __builtin_clz(mx); bit >= 0; --bit) {
                    const unsigned cand = Tacc | (1u << bit);
                    if (cand <= mx) { int c; P16_COUNT(c, cand);
                        if (c >= TOPK) { Tacc = cand; if (c == TOPK) { exact = true; break; } } }
                }
                if (exact) { T16 = Tacc - 1u; r = 0; }
                else { T16 = Tacc; int cgt = 0; if (T16 < 65535u) P16_COUNT(cgt, T16 + 1u); r = TOPK - cgt; }
            }
            unsigned W0 = 0u, W1 = 0u, E0 = 0u, E1 = 0u;
            { const unsigned ts_ = T16 * 0x00010001u; const unsigned two2 = 0x00020002u;
#define P16_FL8(dst, base, cs) do { unsigned t0_, t1_, t2_, t3_, t4_, t5_, t6_, t7_; \
    asm("v_pk_sub_u16 %1, %9, %17 clamp\n\tv_pk_sub_u16 %2, %10, %17 clamp\n\tv_pk_sub_u16 %3, %11, %17 clamp\n\tv_pk_sub_u16 %4, %12, %17 clamp\n\t" \
        "v_pk_sub_u16 %5, %13, %17 clamp\n\tv_pk_sub_u16 %6, %14, %17 clamp\n\tv_pk_sub_u16 %7, %15, %17 clamp\n\tv_pk_sub_u16 %8, %16, %17 clamp\n\t" \
        "v_pk_min_u16 %1, %1, %18\n\tv_pk_min_u16 %2, %2, %18\n\tv_pk_min_u16 %3, %3, %18\n\tv_pk_min_u16 %4, %4, %18\n\t" \
        "v_pk_min_u16 %5, %5, %18\n\tv_pk_min_u16 %6, %6, %18\n\tv_pk_min_u16 %7, %7, %18\n\tv_pk_min_u16 %8, %8, %18\n\t" \
        "v_pk_mad_u16 %0, %0, %19, %1\n\tv_pk_mad_u16 %0, %0, %19, %2\n\tv_pk_mad_u16 %0, %0, %19, %3\n\tv_pk_mad_u16 %0, %0, %19, %4\n\t" \
        "v_pk_mad_u16 %0, %0, %19, %5\n\tv_pk_mad_u16 %0, %0, %19, %6\n\tv_pk_mad_u16 %0, %0, %19, %7\n\tv_pk_mad_u16 %0, %0, %19, %8" \
        : "+v"(dst), "=&v"(t0_), "=&v"(t1_), "=&v"(t2_), "=&v"(t3_), "=&v"(t4_), "=&v"(t5_), "=&v"(t6_), "=&v"(t7_) \
        : "v"(x[(base) + 0]), "v"(x[(base) + 1]), "v"(x[(base) + 2]), "v"(x[(base) + 3]), "v"(x[(base) + 4]), "v"(x[(base) + 5]), "v"(x[(base) + 6]), "v"(x[(base) + 7]), "s"(cs), "v"(one2), "v"(two2)); } while (0)
#define P16_FLAGS_ALL(A0, A1, cs) do { P16_FL8(A0, 0, cs); if (nr > 8) P16_FL8(A0, 8, cs); else A0 = (A0 & 0x00ff00ffu) << 8; \
    if (nr > 16) { P16_FL8(A1, 16, cs); if (nr > 24) P16_FL8(A1, 24, cs); else A1 = (A1 & 0x00ff00ffu) << 8; } } while (0)
              P16_FLAGS_ALL(W0, W1, ts_);
              if (r > 0) {
                  const unsigned es_ = (T16 - 1u) * 0x00010001u;
                  P16_FLAGS_ALL(E0, E1, es_);
                  E0 &= ~W0; E1 &= ~W1;
                  for (int pick = 0; pick < r; ++pick) {
                      unsigned kmine = 0xffffu, pb = 0u; int wsel = 0;
#define E_CAND(E, sh, base, half) do { const unsigned f_ = ((E) >> (sh)) & 0xffffu; if (f_) { const int p_ = __builtin_clz(f_) - 16; const unsigned k_ = (unsigned)(128 * ((base) + p_) + 2 * lane + (half)); \
    if (k_ < kmine) { kmine = k_; pb = (0x8000u >> p_) << (sh); wsel = (base) >> 4; } } } while (0)
                      E_CAND(E0, 0, 0, 0); E_CAND(E0, 16, 0, 1); E_CAND(E1, 0, 16, 0); E_CAND(E1, 16, 16, 1);
#undef E_CAND
                      const unsigned kmin = ~wave_max_u(~kmine);
                      if (kmine == kmin && kmin != 0xffffu) { if (wsel == 0) { E0 &= ~pb; W0 |= pb; } else { E1 &= ~pb; W1 |= pb; } }
                  }
              }
#undef P16_FLAGS_ALL
#undef P16_FL8
            }
            const int mycnt = __builtin_popcount(W0) + __builtin_popcount(W1);
            const int incl = wave_prefix_incl(mycnt);
            int pos = incl - mycnt;
            while (__ballot((W0 | W1) != 0u)) {
                if (W0) { const int p_ = __builtin_clz(W0); IDX[pos] = (unsigned short)(128 * (p_ & 15) + 2 * lane + 1 - (p_ >> 4)); ++pos; W0 &= ~(0x80000000u >> p_); }
                else if (W1) { const int p_ = __builtin_clz(W1); IDX[pos] = (unsigned short)(128 * (16 + (p_ & 15)) + 2 * lane + 1 - (p_ >> 4)); ++pos; W1 &= ~(0x80000000u >> p_); }
            }
            const int total = __builtin_amdgcn_readlane(incl, 63);
            for (int s = total + lane; s < TOPK; s += 64) IDX[s] = 0;
#undef P16_COUNT
#undef P16_BLOCK8
        }
#else
        {
            const int n = tcur + 1, ni = (n + 63) >> 6, thr = n - lane;
            unsigned u[64];
            { const LAS unsigned* S = (const LAS unsigned*)myreg;
#define ULOAD(i) do { const unsigned bits = S[64 * (i) + lane]; const unsigned ord = bits ^ ((unsigned)((int)bits >> 31) | 0x80000000u); u[i] = (64 * (i) < thr) ? ord : 0u; } while (0)
#pragma unroll
              for (int i = 0; i < 16; ++i) ULOAD(i);
              if (ni > 16) {
#pragma unroll
                  for (int i = 16; i < 32; ++i) ULOAD(i); }
              else {
#pragma unroll
                  for (int i = 16; i < 32; ++i) u[i] = 0u; }
              if (ni > 32) {
#pragma unroll
                  for (int i = 32; i < 48; ++i) ULOAD(i); }
              else {
#pragma unroll
                  for (int i = 32; i < 48; ++i) u[i] = 0u; }
              if (ni > 48) {
#pragma unroll
                  for (int i = 48; i < 64; ++i) ULOAD(i); }
              else {
#pragma unroll
                  for (int i = 48; i < 64; ++i) u[i] = 0u; }
#undef ULOAD
            }
            asm volatile("" :: "v"(u[0]), "v"(u[15]), "v"(u[31]), "v"(u[63]) : "memory");
#if !defined(SEL_RADIX)
            wg_arrive(cnt2, lane);
#endif
            unsigned T = 0u; int kb = 0;
#if defined(SEL_RADIX)
            if (n > TOPK) {
                unsigned prefix = 0u; int need = TOPK; bool done = false;
                for (int L = 0; L < 3 && !done; ++L) {
                    const int sh = (L == 0) ? 21 : (L == 1) ? 10 : 0, bits_ = (L == 2) ? 10 : 11, hsh = sh + bits_;
                    const int bpl = (L == 2) ? 16 : 32;
                    LDS_WAIT();
#pragma unroll
                    for (int k = 0; k < 8; ++k) *(LAS u32x4*)(myreg + k * 1024 + lane * 16) = (u32x4){0u, 0u, 0u, 0u};
                    if (L == 0) {
#define HADD0(i) (void)__hip_atomic_fetch_add((LAS unsigned*)(myreg + ((u[i] >> 19) & 0x1FFCu)), 1u, __ATOMIC_RELAXED, __HIP_MEMORY_SCOPE_WORKGROUP)
#pragma unroll
                        for (int i = 0; i < 16; ++i) HADD0(i);
                        if (ni > 16) {
#pragma unroll
                            for (int i = 16; i < 32; ++i) HADD0(i); }
                        if (ni > 32) {
#pragma unroll
                            for (int i = 32; i < 48; ++i) HADD0(i); }
                        if (ni > 48) {
#pragma unroll
                            for (int i = 48; i < 64; ++i) HADD0(i); }
#undef HADD0
                    } else {
#define HADD(i) do { const unsigned x_ = u[i]; if ((x_ >> hsh) == prefix) \
                        (void)__hip_atomic_fetch_add((LAS unsigned*)(myreg + (__builtin_amdgcn_ubfe(x_, sh, bits_) << 2)), 1u, __ATOMIC_RELAXED, __HIP_MEMORY_SCOPE_WORKGROUP); } while (0)
#pragma unroll
                        for (int i = 0; i < 16; ++i) HADD(i);
                        if (ni > 16) {
#pragma unroll
                            for (int i = 16; i < 32; ++i) HADD(i); }
                        if (ni > 32) {
#pragma unroll
                            for (int i = 32; i < 48; ++i) HADD(i); }
                        if (ni > 48) {
#pragma unroll
                            for (int i = 48; i < 64; ++i) HADD(i); }
#undef HADD
                    }
                    LDS_WAIT();
                    int mysum = 0;
                    if (L == 2) {
#pragma unroll
                        for (int k = 0; k < 4; ++k) { const u32x4 h4 = *(const LAS u32x4*)(myreg + lane * 64 + k * 16); mysum += (int)(h4.x + h4.y + h4.z + h4.w); }
                    } else {
#pragma unroll
                        for (int k = 0; k < 8; ++k) { const u32x4 h4 = *(const LAS u32x4*)(myreg + lane * 128 + k * 16); mysum += (int)(h4.x + h4.y + h4.z + h4.w); }
                    }
                    int ex1, v1; const int L1 = sfx_find(mysum, need, ex1, v1);
                    const int hv = (lane < bpl) ? (int)((LAS unsigned*)myreg)[L1 * bpl + lane] : 0;
                    int ex2, v2; const int j2 = sfx_find(hv, need - ex1, ex2, v2);
                    const unsigned bin = (unsigned)(L1 * bpl + j2);
                    const int nn = need - ex1 - ex2;
                    prefix = (prefix << bits_) | bin; need = nn;
                    if (v2 == nn) { T = (prefix << sh) - 1u; kb = 0; done = true; }
                }
                if (!done) {
                    T = prefix; const int r = need; int kacc = 0;
                    for (int bit = 12; bit >= 0; --bit) { const int kc = kacc | (1 << bit); int c;
#define P_EQK(x, k) ((x) == T && (k) < kc)
                        SEL_COUNT(c, ni, P_EQK);
#undef P_EQK
                        if (c <= r) kacc = kc; }
                    kb = kacc;
                }
            }
            wg_arrive(cnt2, lane);
#else
            if (n > TOPK) {
                unsigned mxl = u[0];
#pragma unroll
                for (int i = 1; i < 64; ++i) mxl = mxl > u[i] ? mxl : u[i];
                const unsigned mx = wave_max_u(mxl);
                unsigned Tacc = 0u; bool exact = false;
                for (int bit = 31 - __builtin_clz(mx); bit >= 0; --bit) {
                    const unsigned cand = Tacc | (1u << bit);
                    if (cand <= mx) {
                        int a0_ = 0, a1_ = 0; const unsigned cm1_ = cand - 1u;
                        GE3_BLOCK8(a0_, a1_, 0, cm1_); GE3_BLOCK8(a0_, a1_, 8, cm1_);
                        if (ni > 16) { GE3_BLOCK8(a0_, a1_, 16, cm1_); GE3_BLOCK8(a0_, a1_, 24, cm1_); }
                        if (ni > 32) { GE3_BLOCK8(a0_, a1_, 32, cm1_); GE3_BLOCK8(a0_, a1_, 40, cm1_); }
                        if (ni > 48) { GE3_BLOCK8(a0_, a1_, 48, cm1_); GE3_BLOCK8(a0_, a1_, 56, cm1_); }
                        const int c = __builtin_amdgcn_readlane(wave_prefix_incl(a0_ + a1_), 63);
                        if (c >= TOPK) { Tacc = cand; if (c == TOPK) { exact = true; break; } }
                    }
                }
                if (exact) { T = Tacc - 1u; kb = 0; }
                else {
                    T = Tacc; int cgt;
#define P_GT(x, k) ((x) > T)
                    SEL_COUNT(cgt, ni, P_GT);
#undef P_GT
                    const int r = TOPK - cgt; int kacc = 0;
                    for (int bit = 12; bit >= 0; --bit) { const int kc = kacc | (1 << bit); int c;
#define P_EQK(x, k) ((x) == T && (k) < kc)
                        SEL_COUNT(c, ni, P_EQK);
#undef P_EQK
                        if (c <= r) kacc = kc; }
                    kb = kacc;
                }
            }
#endif
            unsigned mlo = 0u, mhi = 0u;
#pragma unroll
            for (int i = 0; i < 32; ++i) mlo = mlo + mlo + ((u[i] > T) ? 1u : 0u);
#pragma unroll
            for (int i = 32; i < 64; ++i) mhi = mhi + mhi + ((u[i] > T) ? 1u : 0u);
            if (kb > 0) {
                unsigned elo = 0u, ehi = 0u;
#pragma unroll
                for (int i = 0; i < 32; ++i) elo = elo + elo + ((u[i] == T && (64 * i + lane) < kb) ? 1u : 0u);
#pragma unroll
                for (int i = 32; i < 64; ++i) ehi = ehi + ehi + ((u[i] == T && (64 * i + lane) < kb) ? 1u : 0u);
                mlo |= elo; mhi |= ehi;
            }
            const int mycnt = __builtin_popcount(mlo) + __builtin_popcount(mhi);
            const int incl = wave_prefix_incl(mycnt);
            int pos = incl - mycnt;
            while (__ballot((mlo | mhi) != 0u)) {
                if (mlo) { const int i = __builtin_clz(mlo); IDX[pos] = (unsigned short)(64 * i + lane); ++pos; mlo &= ~(0x80000000u >> i); }
                else if (mhi) { const int i = __builtin_clz(mhi); IDX[pos] = (unsigned short)(64 * (32 + i) + lane); ++pos; mhi &= ~(0x80000000u >> i); }
            }
            const int total = __builtin_amdgcn_readlane(incl, 63);
            for (int s = total + lane; s < TOPK; s += 64) IDX[s] = 0;
        }
#endif
        if (wave < 4) ATTN_BLOCK();
        tprev = tcur; lprev = IDX;
        { const int hd_ = lr_ & 15, qq4_ = lr_ >> 4; if (hd_ < NH) { const f16_t* qp = F.Q + (rowbase + tcur) * AW + hd_ * HD + 8 * qq4_; bqn0 = *(const f16x8*)qp; bqn1 = *(const f16x8*)(qp + 32); } }
    }
    ATTN_BLOCK();
    for (;;) {
        unsigned g1_ = 0u; if (lane == 0) g1_ = __hip_atomic_fetch_add((LAS unsigned*)(F.MISC + 56), 1u, __ATOMIC_RELAXED, __HIP_MEMORY_SCOPE_WORKGROUP);
        const int cr = __builtin_amdgcn_readfirstlane((int)g1_);
        if (cr >= 256) break;
        conv_row_one(F, F.vcu * 256 + cr, lane);
    }
#undef ATTN_BLOCK
#undef KIX
#undef VIX
#undef STASH_LOAD
#undef STASH_STORE
}

#ifndef MK_N_LAUNCHES
#define MK_N_LAUNCHES 1
#endif
constexpr int N_PHASES = 9;
constexpr int N_LAUNCHES = MK_N_LAUNCHES;
struct Args { const float* in[16]; float* out; unsigned char* ws; int ph_lo, ph_hi; };
static_assert(sizeof(Args) == 16 * 8 + 8 + 8 + 8, "Args has no padding");

__global__ void __launch_bounds__(NWAVES * 64, 2) hymba_fwd(Args args) {
    extern __shared__ __attribute__((aligned(16))) unsigned char lds[];
    Frame F;
    F.lds = (LAS unsigned char*)lds;
    F.MISC = (volatile LAS unsigned*)(F.lds + MISC_OFF);
    F.tid = threadIdx.x; F.lane = F.tid & 63; F.wave = __builtin_amdgcn_readfirstlane(F.tid >> 6);
    F.G = gridDim.x; { const int bx = blockIdx.x; F.vcu = (F.G % 8 == 0) ? (bx % 8) * (F.G / 8) + bx / 8 : bx; }
    unsigned char* ws = args.ws;
    F.ctl = (unsigned*)(ws + WS_CTL);
    F.x = args.in[0]; F.c = args.in[1]; F.w_ada = args.in[2]; F.b_ada = args.in[3]; F.w_in = args.in[4]; F.conv_w = args.in[5]; F.attn_g = args.in[6]; F.conv_g = args.in[7];
    F.w_out = args.in[8]; F.ln1_g = args.in[9]; F.ln1_b = args.in[10]; F.w_gate = args.in[11]; F.w_up = args.in[12]; F.w_down = args.in[13]; F.ln2_g = args.in[14]; F.ln2_b = args.in[15];
    F.out = args.out;
    F.MODP = (float*)(ws + WS_MODP); F.MOD = (float*)(ws + WS_MOD); F.ROPE = (float*)(ws + WS_ROPE); F.WI = (float*)(ws + WS_WI); F.X1H = (f16_t*)(ws + WS_X1); F.YH = (f16_t*)(ws + WS_X1 + 128 * MiB);
    F.WIN = (f16_t*)(ws + WS_WIN); F.WOUT = (f16_t*)(ws + WS_WOUT); F.WGU = (f16_t*)(ws + WS_WGU); F.WDN = (f16_t*)(ws + WS_WDN); F.XN = (f16_t*)(ws + WS_XN);
    F.Q = (f16_t*)(ws + WS_Q); F.K = (f16_t*)(ws + WS_K); F.V = (f16_t*)(ws + WS_V); F.QI = (f16_t*)(ws + WS_QI); F.KI = (f16_t*)(ws + WS_KI);
    F.GB = (f16_t*)(ws + WS_GB); F.U = (f16_t*)(ws + WS_U); F.MIX = (f16_t*)(ws + WS_MIX); F.H = (f16_t*)(ws + WS_H);
    for (int u = F.tid; u < (LDS_BYTES - LDSCTL_OFF) / 4; u += NWAVES * 64) ((LAS unsigned*)(F.lds + LDSCTL_OFF))[u] = 0u;
    __syncthreads();
    XcdBarrier bar; bar.bar = (unsigned*)(F.ctl + CW_BAR); bar.x = 0; bar.st = nullptr;
    if (N_LAUNCHES == 1) bar = xcd_barrier_post((unsigned*)(F.ctl + CW_BAR), F.MISC + 8);
    const int lo = args.ph_lo, hi = args.ph_hi;
#define IN(k) (lo <= (k) && (k) < hi)
#define SEAM(k) do { if (IN(k) && IN((k) + 1)) xcd_barrier(bar); } while (0)

    if (IN(0)) { p0_prologue(F); } SEAM(0);
    if (IN(1)) { p1_modulate(F); } SEAM(1);
    if (IN(2)) {
        pg8::Gemm g{F.XN, F.WIN, MTOK, NIN, DM}; pg8::StaticOrder S; S.init(MTOK, NIN, F.G, (int)blockIdx.x);
        pg8::EpiInProj E{F.Q, F.K, F.V, F.QI, F.KI, F.GB, F.U, F.WI, F.ROPE};
        pg8::gemm_phase<pg8::EpiInProj, pg8::StaticOrder, true, true>(F.lds + RING_OFF, g, S, E);
    } SEAM(2);
    if (IN(3)) {
        if (F.G == 256) sa_phase(F);
        else conv_rows(F);
    } SEAM(3);
    if (IN(4)) {
        pg8::Gemm g{F.MIX, F.WOUT, MTOK, DM, DM}; pg8::StaticOrder S; S.init(MTOK, DM, F.G, (int)blockIdx.x);
        pg8::EpiResGate<false> E{F.x, F.YH, F.MOD + 2 * DM};
        pg8::gemm_phase<pg8::EpiResGate<false>, pg8::StaticOrder, true, true>(F.lds + RING_OFF, g, S, E);
    } SEAM(4);
    if (IN(5)) { ln_rows<0>(F, F.YH, F.ln1_g, F.ln1_b); } SEAM(5);
    if (IN(6)) {
        pg8::Gemm g{F.XN, F.WGU, MTOK, NGU, DM}; pg8::StaticOrder S; S.init(MTOK, NGU, F.G, (int)blockIdx.x);
        pg8::EpiSwiGLU E{F.H};
        pg8::gemm_phase<pg8::EpiSwiGLU, pg8::StaticOrder, true, true, FFN_BF>(F.lds + RING_OFF, g, S, E);
    } SEAM(6);
    if (IN(7)) {
        pg8::Gemm g{F.H, F.WDN, MTOK, DM, DFF}; pg8::StaticOrder S; S.init(MTOK, DM, F.G, (int)blockIdx.x);
        pg8::EpiResGate<true> E{F.X1H, F.YH, F.MOD + 5 * DM};
        pg8::gemm_phase<pg8::EpiResGate<true>, pg8::StaticOrder, true, true, FFN_BF>(F.lds + RING_OFF, g, S, E);
    } SEAM(7);
    if (IN(8)) { ln_rows<1>(F, F.YH, F.ln2_g, F.ln2_b); }
#undef IN
#undef SEAM
}

extern "C" void kernel_launch(void* const* d_in, const int* in_sizes, int n_in, void* d_out, int out_size, void* d_ws, size_t ws_size, hipStream_t stream) {
    static int grid = 0;
    if (grid == 0) {
        if (n_in != 16 || in_sizes[0] != MTOK * DM || out_size != MTOK * DM || ws_size < WS_END) { fprintf(stderr, "kernel_launch: unexpected shapes (n_in %d, in0 %d, out %d, ws %zu)\n", n_in, n_in > 0 ? in_sizes[0] : -1, out_size, ws_size); grid = -1; return; }
        int dev = 0, cus = 0, per_cu = 0;
        if (hipGetDevice(&dev) != hipSuccess || hipDeviceGetAttribute(&cus, hipDeviceAttributeMultiprocessorCount, dev) != hipSuccess) { fprintf(stderr, "kernel_launch: device query failed\n"); grid = -1; return; }
        if (hipFuncSetAttribute((const void*)hymba_fwd, hipFuncAttributeMaxDynamicSharedMemorySize, LDS_BYTES) != hipSuccess) { fprintf(stderr, "kernel_launch: hipFuncSetAttribute failed\n"); grid = -1; return; }
        if (hipOccupancyMaxActiveBlocksPerMultiprocessor(&per_cu, (const void*)hymba_fwd, NWAVES * 64, LDS_BYTES) != hipSuccess || per_cu < 1) { fprintf(stderr, "kernel_launch: occupancy query reports %d workgroups per CU\n", per_cu); per_cu = 1; }
        (void)hipGetLastError();
        grid = cus;
        if (grid != 256) fprintf(stderr, "kernel_launch: %d CUs; the attention phase needs 256\n", grid);
    }
    if (grid < 0) return;
    if (hipMemsetAsync((char*)d_ws + WS_CTL, 0, CTL_ZERO_BYTES, stream) != hipSuccess) { fprintf(stderr, "kernel_launch: memset failed\n"); return; }
    Args a{};
    for (int i = 0; i < 16; ++i) a.in[i] = (const float*)d_in[i];
    a.out = (float*)d_out; a.ws = (unsigned char*)d_ws;
    for (int li = 0; li < N_LAUNCHES; ++li) {
        a.ph_lo = (N_LAUNCHES == 1) ? 0 : li; a.ph_hi = (N_LAUNCHES == 1) ? N_PHASES : li + 1;
        hipLaunchKernelGGL(hymba_fwd, dim3(grid), dim3(NWAVES * 64), LDS_BYTES, stream, a);
#if defined(REP_MASK)
        if (N_LAUNCHES != 1 && (((REP_MASK) >> li) & 1)) hipLaunchKernelGGL(hymba_fwd, dim3(grid), dim3(NWAVES * 64), LDS_BYTES, stream, a);
#endif
        const hipError_t le = hipPeekAtLastError();
        if (le != hipSuccess) { fprintf(stderr, "kernel_launch: launch %d failed: %s\n", li, hipGetErrorName(le)); break; }
    }
}
```
